# Optimizing an MI355X kernel written in HIP

```python
import jax, jax.numpy as jnp
from jax import lax
import numpy as np

D_MODEL = 1024
BATCH = 2
SEQ = 16384
DEPTH = 2

DENSE_HEAD_DIM = 128
N_FOX_HEADS = 4
N_SB_HEADS = 4
FOX_W = N_FOX_HEADS * DENSE_HEAD_DIM
SB_W = N_SB_HEADS * DENSE_HEAD_DIM
EVEN_WIDTH = FOX_W + SB_W
EVEN_SIZES = (FOX_W, FOX_W, FOX_W, N_FOX_HEADS, SB_W, SB_W, SB_W, EVEN_WIDTH)
EVEN_IN = sum(EVEN_SIZES)
DIL_HEAD_DIM = 64
DILATED_PAIRS = ((128, 1), (512, 4), (2048, 16))
N_DIL_GROUPS = len(DILATED_PAIRS)
N_DIL_HEADS = 8
DIL_W = N_DIL_GROUPS * N_DIL_HEADS * DIL_HEAD_DIM
ODD_WIDTH = N_DIL_HEADS * DIL_HEAD_DIM
ODD_SIZES = (DIL_W, DIL_W, DIL_W, ODD_WIDTH)
ODD_IN = sum(ODD_SIZES)
Q_BLOCK = 128
RMS_EPS = 1e-6
N_EVEN = (DEPTH + 1) // 2
N_ODD = DEPTH // 2

kernel_name = "hybrid_fox_stickbreak_dilated_gated"


def rmsnorm(x, g):
    xf = x.astype(jnp.float32)
    y = xf * lax.rsqrt(jnp.mean(xf * xf, axis=-1, keepdims=True) + RMS_EPS)
    return (y * g.astype(jnp.float32)).astype(x.dtype)


def split_points(sizes):
    return np.cumsum(np.array(sizes))[:-1].tolist()


def split_heads(t, n, hd):
    b, s, _ = t.shape
    return t.reshape(b, s, n, hd).transpose(0, 2, 1, 3)


def merge_heads(t):
    b, n, s, hd = t.shape
    return t.transpose(0, 2, 1, 3).reshape(b, s, n * hd)


def alibi_slopes(n):
    return jnp.asarray(2.0 ** (-8.0 * np.arange(1, n + 1) / n), dtype=jnp.float32)


def forgetting_attention(q, k, v, log_f):
    s = q.shape[2]
    q = q * jnp.asarray(DENSE_HEAD_DIM ** -0.5, q.dtype)
    cum = jnp.cumsum(log_f, axis=-1)
    outs = []
    for i in range(s // Q_BLOCK):
        start, end = i * Q_BLOCK, (i + 1) * Q_BLOCK
        qpos = start + jnp.arange(Q_BLOCK)
        causal = jnp.arange(end)[None, :] <= qpos[:, None]
        logits = jnp.einsum('bhqd,bhkd->bhqk', q[:, :, start:end], k[:, :, :end]).astype(jnp.float32)
        logits = logits + (cum[:, :, start:end, None] - cum[:, :, None, :end])
        p = jax.nn.softmax(jnp.where(causal, logits, -jnp.inf), axis=-1)
        outs.append(jnp.einsum('bhqk,bhkd->bhqd', p.astype(v.dtype), v[:, :, :end]))
    return jnp.concatenate(outs, axis=2)


def stick_breaking_attention(q, k, v):
    b, h, s, _ = q.shape
    q = q * jnp.asarray(DENSE_HEAD_DIM ** -0.5, q.dtype)
    c = jnp.arange(Q_BLOCK)
    upper_incl = (c[:, None] >= c[None, :]).astype(jnp.float32)
    outs = []
    for i in range(s // Q_BLOCK):
        start, end = i * Q_BLOCK, (i + 1) * Q_BLOCK
        nb = i + 1
        qpos = start + jnp.arange(Q_BLOCK)
        strict = jnp.arange(end)[None, :] < qpos[:, None]
        z = jnp.einsum('bhqd,bhkd->bhqk', q[:, :, start:end], k[:, :, :end]).astype(jnp.float32)
        log_beta = jax.nn.log_sigmoid(z)
        log_one_minus = jnp.where(strict, log_beta - z, 0.0)
        lob = log_one_minus.reshape(b, h, Q_BLOCK, nb, Q_BLOCK)
        incl = jnp.einsum('bhqnc,cd->bhqnd', lob, upper_incl)
        n_idx = jnp.arange(nb)
        later_blocks = (n_idx[:, None] > n_idx[None, :]).astype(jnp.float32)
        off = jnp.einsum('bhqn,nm->bhqm', jnp.sum(lob, axis=-1), later_blocks)
        later = (incl - lob + off[..., None]).reshape(b, h, Q_BLOCK, end)
        w = jnp.where(strict, jnp.exp(log_beta + later), 0.0)
        outs.append(jnp.einsum('bhqk,bhkd->bhqd', w.astype(v.dtype), v[:, :, :end]))
    return jnp.concatenate(outs, axis=2)


def dilated_group(q, k, v, window, dil, slopes):
    b, h, s, hd = q.shape
    length = s // dil
    blk = min(Q_BLOCK, length)
    nblk = length // blk
    span = window // dil

    def residues(t):
        return t.reshape(b, h, length, dil, hd).transpose(0, 1, 3, 2, 4).reshape(b, h, dil, nblk, blk, hd)

    def with_prev(t):
        prev = jnp.pad(t[:, :, :, :-1], ((0, 0), (0, 0), (0, 0), (1, 0), (0, 0), (0, 0)))
        return jnp.concatenate([prev, t], axis=4)

    qb = residues(q) * jnp.asarray(DIL_HEAD_DIM ** -0.5, q.dtype)
    kw = with_prev(residues(k))
    vw = with_prev(residues(v))
    a = jnp.arange(blk)[:, None]
    c = jnp.arange(2 * blk)[None, :]
    dist_sub = a - c + blk
    key_idx = jnp.arange(nblk)[:, None, None] * blk + c[None] - blk
    valid = (dist_sub >= 0) & (dist_sub <= span) & (key_idx >= 0)
    logits = jnp.einsum('bhrnqd,bhrnkd->bhrnqk', qb, kw).astype(jnp.float32)
    logits = logits - slopes[:, None, None, None, None] * (dist_sub * dil).astype(jnp.float32)
    logits = jnp.where(valid, logits, -jnp.inf)
    m = jnp.max(logits, axis=-1, keepdims=True)
    p = jnp.exp(logits - m)
    den = jnp.sum(p, axis=-1)
    o = jnp.einsum('bhrnqk,bhrnkd->bhrnqd', p.astype(vw.dtype), vw).astype(jnp.float32) / den[..., None]

    def back(t):
        extra = t.shape[5:]
        t = t.reshape(b, h, dil, length, *extra)
        t = jnp.moveaxis(t, 2, 3)
        return t.reshape(b, h, s, *extra)

    return back(o), back(m[..., 0]), back(den)


def dilated_window_attention(q, k, v):
    slopes = alibi_slopes(N_DIL_GROUPS * N_DIL_HEADS).reshape(N_DIL_GROUPS, N_DIL_HEADS)
    maxes, dens, outs = [], [], []
    for g, (window, dil) in enumerate(DILATED_PAIRS):
        o, m, den = dilated_group(q[g], k[g], v[g], window, dil, slopes[g])
        maxes.append(m); dens.append(den); outs.append(o)
    m_all = jnp.stack(maxes)
    den_all = jnp.stack(dens)
    o_all = jnp.stack(outs)
    wts = den_all * jnp.exp(m_all - jnp.max(m_all, axis=0))
    wts = wts / jnp.sum(wts, axis=0)
    return jnp.sum(wts[..., None] * o_all, axis=0).astype(v.dtype)


def even_layer(x, g_norm, w_in, b_f, g_q, g_k, w_out):
    h = rmsnorm(x, g_norm)
    proj = h @ w_in
    fq, fk, fv, f_logit, sq, sk, sv, gate = jnp.split(proj, split_points(EVEN_SIZES), axis=-1)
    log_f = jax.nn.log_sigmoid((f_logit + b_f).astype(jnp.float32)).transpose(0, 2, 1)
    fq = rmsnorm(split_heads(fq, N_FOX_HEADS, DENSE_HEAD_DIM), g_q)
    fk = rmsnorm(split_heads(fk, N_FOX_HEADS, DENSE_HEAD_DIM), g_k)
    fox = forgetting_attention(fq, fk, split_heads(fv, N_FOX_HEADS, DENSE_HEAD_DIM), log_f)
    sb = stick_breaking_attention(split_heads(sq, N_SB_HEADS, DENSE_HEAD_DIM),
                                  split_heads(sk, N_SB_HEADS, DENSE_HEAD_DIM),
                                  split_heads(sv, N_SB_HEADS, DENSE_HEAD_DIM))
    mixed = jnp.concatenate([merge_heads(fox), merge_heads(sb)], axis=-1) * jax.nn.silu(gate)
    return x + mixed @ w_out


def odd_layer(x, g_norm, w_in, g_q, g_k, w_out):
    h = rmsnorm(x, g_norm)
    proj = h @ w_in
    q, k, v, gate = jnp.split(proj, split_points(ODD_SIZES), axis=-1)
    b, s, _ = x.shape

    def groups(t):
        return t.reshape(b, s, N_DIL_GROUPS, N_DIL_HEADS, DIL_HEAD_DIM).transpose(2, 0, 3, 1, 4)

    q = rmsnorm(groups(q), g_q)
    k = rmsnorm(groups(k), g_k)
    att = dilated_window_attention(q, k, groups(v))
    mixed = merge_heads(att) * jax.nn.silu(gate)
    return x + mixed @ w_out


def setup_inputs(seed: int = 0) -> dict:
    key = jax.random.key(seed)
    ks = jax.random.split(key, 13)
    f32 = jnp.float32
    x = jax.random.normal(ks[0], (BATCH, SEQ, D_MODEL), f32)
    even_norm = 1.0 + 0.02 * jax.random.normal(ks[1], (N_EVEN, D_MODEL), f32)
    even_w_in = jax.random.normal(ks[2], (N_EVEN, D_MODEL, EVEN_IN), f32) * D_MODEL ** -0.5
    even_b_f = (jnp.linspace(1.0, 4.0, N_FOX_HEADS, dtype=f32)[None, :]
                + 0.1 * jax.random.normal(ks[3], (N_EVEN, N_FOX_HEADS), f32))
    even_q_gain = 1.0 + 0.02 * jax.random.normal(ks[4], (N_EVEN, DENSE_HEAD_DIM), f32)
    even_k_gain = 1.0 + 0.02 * jax.random.normal(ks[5], (N_EVEN, DENSE_HEAD_DIM), f32)
    even_w_out = jax.random.normal(ks[6], (N_EVEN, EVEN_WIDTH, D_MODEL), f32) * EVEN_WIDTH ** -0.5
    odd_norm = 1.0 + 0.02 * jax.random.normal(ks[7], (N_ODD, D_MODEL), f32)
    odd_w_in = jax.random.normal(ks[8], (N_ODD, D_MODEL, ODD_IN), f32) * D_MODEL ** -0.5
    odd_q_gain = 1.0 + 0.02 * jax.random.normal(ks[9], (N_ODD, DIL_HEAD_DIM), f32)
    odd_k_gain = 1.0 + 0.02 * jax.random.normal(ks[10], (N_ODD, DIL_HEAD_DIM), f32)
    odd_w_out = jax.random.normal(ks[11], (N_ODD, ODD_WIDTH, D_MODEL), f32) * ODD_WIDTH ** -0.5
    return {"x": x, "even_norm": even_norm, "even_w_in": even_w_in, "even_b_f": even_b_f,
            "even_q_gain": even_q_gain, "even_k_gain": even_k_gain, "even_w_out": even_w_out,
            "odd_norm": odd_norm, "odd_w_in": odd_w_in, "odd_q_gain": odd_q_gain,
            "odd_k_gain": odd_k_gain, "odd_w_out": odd_w_out}


def reference(x, even_norm, even_w_in, even_b_f, even_q_gain, even_k_gain, even_w_out,
              odd_norm, odd_w_in, odd_q_gain, odd_k_gain, odd_w_out):
    h = x
    for layer in range(DEPTH):
        i = layer // 2
        if layer % 2 == 0:
            h = even_layer(h, even_norm[i], even_w_in[i], even_b_f[i], even_q_gain[i],
                           even_k_gain[i], even_w_out[i])
        else:
            h = odd_layer(h, odd_norm[i], odd_w_in[i], odd_q_gain[i], odd_k_gain[i], odd_w_out[i])
    return h
```

```cpp
#include <hip/hip_runtime.h>
#include <hip/hip_cooperative_groups.h>
#include <cstdio>
#include <cstdint>
namespace cg = cooperative_groups;
namespace pg8 {
#define PG8_LAS __attribute__((address_space(3)))
typedef unsigned short bf16_t;
typedef short bf16x8 __attribute__((ext_vector_type(8)));
typedef float f32x4 __attribute__((ext_vector_type(4)));
typedef unsigned u32x4 __attribute__((ext_vector_type(4)));
constexpr int BM = 256, BK = 64, HALF = 128, HTB = HALF * BK * 2  , STAGE_BYTES = 8 * HTB, NXCD = 8, WGM = 4;

__host__ __device__ __forceinline__ int lds_byte(int r, int c) { const int st = (r >> 4) * 2 + (c >> 5), rr = r & 15, cc = c & 31, ob = rr * 64 + cc * 2; return st * 1024 + (ob ^ (((ob >> 9) & 1) << 5)); }
__host__ __device__ __forceinline__ void stage_rc(int b, int& R, int& C) { const int st = b / 1024, sb = b % 1024, swz = sb ^ (((sb >> 9) & 1) << 5); R = (st >> 1) * 16 + swz / 64; C = (st & 1) * 32 + (swz % 64) / 2; }
__host__ __device__ __forceinline__ int perm32(int rho) { const int n = rho >> 4, i = rho & 15; return 8 * (i >> 2) + 4 * n + (i & 3); }

struct Unit { int pm, pn; };
struct Gemm { const bf16_t* A; const bf16_t* Bt; int M, N, K; int ldb; int dshift; };
__device__ __forceinline__ const char* b_tile(const Gemm& g, int pn) { const int p0 = pn * 256, bb = p0 >> 14, rem = p0 & 16383, ls = 14 - g.dshift, r = rem >> ls, i0 = rem & ((1 << ls) - 1);
    return (const char*)g.Bt + ((size_t)(bb * 16384 + r + (i0 << g.dshift)) * (size_t)g.K) * 2; }

struct StaticOrder {
    int nM, nN, nwg, G, c, wgm;
    __host__ __device__ void init(int M, int N, int G_, int c_, int wgm_ = WGM) { nM = M / BM; nN = N / BM; nwg = nM * nN; G = G_; c = c_; wgm = wgm_; }
    __host__ __device__ bool next(int i, Unit& u) const {
        const long L = (long)i * G + c; if (L >= nwg) return false;
        int wgid = (int)L; { const int q = nwg / NXCD, r = nwg % NXCD, xcd = wgid % NXCD, off = wgid / NXCD; wgid = (xcd < r ? xcd * (q + 1) : r * (q + 1) + (xcd - r) * q) + off; }
        const int nig = wgm * nN, gid = wgid / nig, fm = gid * wgm, gsz = (nM - fm) < wgm ? (nM - fm) : wgm;
        u.pm = fm + ((wgid % nig) % gsz); u.pn = (wgid % nig) / gsz; return true;
    }
    __device__ __forceinline__ void a_ready(const Unit&) const {}
    __device__ __forceinline__ void done(const Unit&) const {}
};
typedef unsigned u32x2 __attribute__((ext_vector_type(2)));
typedef float f32x2v __attribute__((ext_vector_type(2))); typedef __bf16 bf16x2v __attribute__((ext_vector_type(2)));
__device__ __forceinline__ unsigned cvtpk(float lo, float hi) { f32x2v v = {lo, hi}; bf16x2v b = __builtin_convertvector(v, bf16x2v); return __builtin_bit_cast(unsigned, b); }
__device__ __forceinline__ float silu_f(float v) { return v * __builtin_amdgcn_rcpf(1.0f + __builtin_amdgcn_exp2f(-1.4426950408889634f * v)); }
constexpr float RMS_EPS_F = 1e-6f;

struct EpiProj {
    static constexpr bool PERM = true, AFTER_DRAIN = false;
    bf16_t* O; int ldc; const float* ss; int n_qn, n_kn, n_qp, n_kp, hd128; const float* gq; const float* gk; float qscale; PG8_LAS float* scr; bf16_t* KT; int nkh; bf16_t* QT;
    __device__ __forceinline__ unsigned lane_off(bool tiled, int fr, int fq, int dsh) const {
        if (!tiled) return (unsigned)(fr * ldc + 8 * fq);
        const int NS = hd128 ? 8 : 4, r = fr & ((1 << dsh) - 1), il = fr >> dsh;
        return (unsigned)((((r << (9 - dsh)) * nkh * NS + (fq >> 1)) * 512) + (fq & 1) * 256 + il * 8);
    }
    __device__ __forceinline__ unsigned uni_off(bool tiled, int RU, int bj, int tix, int wc, int dsh) const {
        if (!tiled) return (unsigned)(RU * ldc + tix * BM + bj * HALF + wc * 32);
        const int NS = hd128 ? 8 : 4, head = hd128 ? tix * 2 + bj : tix * 4 + bj * 2 + (wc >> 1), sxu = hd128 ? wc * 2 : (wc & 1) * 2;
        const int bb = RU >> 14, q = (RU & 16383) >> dsh, Tu = bb * 512 + (q >> 5), pinu = q & 31;
        return (unsigned)((((Tu * nkh + head) * NS + sxu) * 512) + pinu * 8);
    }
    __device__ __forceinline__ void operator()(const f32x4 (&acc)[2][2][4][2], const Unit& u, int wr, int wc, int fr, int fq) const {
        const int pn = u.pn; int mode, tix; bool isk; const float* gain = gq; float sc = 1.f;
        bf16_t* T = KT;
        if (pn < n_qn) { mode = 2; gain = gq; sc = qscale; isk = (QT != nullptr); tix = pn; T = QT; }
        else if (pn < n_qn + n_kn) { mode = 2; gain = gk; isk = true; tix = pn - n_qn; }
        else if (pn < n_qn + n_kn + n_qp) { mode = 0; sc = qscale; isk = false; tix = pn - n_kn; }
        else if (pn < n_qn + n_kn + n_qp + n_kp) { mode = 0; isk = true; tix = pn - n_qn - n_qp; }
        else { mode = 1; isk = false; tix = pn - n_kn - n_kp; }
        const int rowl0 = wr * 64 + fr;
        const int dsh = hd128 ? 0 : 2 * (tix >> 1);
        bf16_t* const img = isk ? T : O; const unsigned loff = lane_off(isk, fr, fq, dsh);
        float rs[2][4];
#pragma unroll
        for (int ai = 0; ai < 2; ++ai)
#pragma unroll
            for (int m = 0; m < 4; ++m) rs[ai][m] = ss[u.pm * BM + ai * HALF + rowl0 + m * 16];
#pragma unroll
        for (int ai = 0; ai < 2; ++ai)
#pragma unroll
            for (int m = 0; m < 4; ++m) rs[ai][m] = __builtin_amdgcn_rsqf(rs[ai][m] * (1.0f / 1024.0f) + RMS_EPS_F);
        if (mode == 2) {
#pragma unroll
            for (int ai = 0; ai < 2; ++ai)
#pragma unroll
                for (int m = 0; m < 4; ++m)
#pragma unroll
                    for (int bj = 0; bj < 2; ++bj) {
                        const f32x4 a = acc[ai][bj][m][0], b = acc[ai][bj][m][1];
                        float p = (a[0] * a[0] + a[1] * a[1]) + (a[2] * a[2] + a[3] * a[3]) + (b[0] * b[0] + b[1] * b[1]) + (b[2] * b[2] + b[3] * b[3]);
                        p += __builtin_bit_cast(float, __builtin_amdgcn_ds_swizzle(__builtin_bit_cast(int, p), 0x401F));
                        { const auto rr = __builtin_amdgcn_permlane32_swap(__float_as_uint(p), __float_as_uint(p), false, false); p = __uint_as_float(rr[0]) + __uint_as_float(rr[1]); }
                        if (fq == 0) scr[((ai * HALF + rowl0 + m * 16) * 2 + bj) * 4 + wc] = p;
                    }
            asm volatile("s_waitcnt lgkmcnt(0)" ::: "memory"); __builtin_amdgcn_s_barrier(); asm volatile("" ::: "memory");
            const int cih = (hd128 ? wc * 32 : (wc & 1) * 32) + 8 * fq;
            const f32x4 g0 = *(const f32x4*)(gain + cih), g1 = *(const f32x4*)(gain + cih + 4);
            const float inv_hd = hd128 ? (1.0f / 128.0f) : (1.0f / 64.0f);
#pragma unroll
            for (int ai = 0; ai < 2; ++ai)
#pragma unroll
                for (int m = 0; m < 4; ++m) {
                    const int rowl = ai * HALF + rowl0 + m * 16; const int row = u.pm * BM + rowl;
                    const float r = rs[ai][m];
#pragma unroll
                    for (int bj = 0; bj < 2; ++bj) {
                        const f32x4 pp = *(const PG8_LAS f32x4*)(scr + (rowl * 2 + bj) * 4);
                        const float tot = hd128 ? ((pp[0] + pp[1]) + (pp[2] + pp[3])) : ((wc < 2) ? (pp[0] + pp[1]) : (pp[2] + pp[3]));
                        const float f = r * __builtin_amdgcn_rsqf(tot * r * r * inv_hd + RMS_EPS_F) * sc;
                        const f32x4 a = acc[ai][bj][m][0] * g0 * f, b = acc[ai][bj][m][1] * g1 * f;
                        u32x4 w; w.x = cvtpk(a[0], a[1]); w.y = cvtpk(a[2], a[3]); w.z = cvtpk(b[0], b[1]); w.w = cvtpk(b[2], b[3]);
                        *(u32x4*)(img + (uni_off(isk, u.pm * BM + ai * HALF + wr * 64 + m * 16, bj, tix, wc, dsh) + loff)) = w;
                    }
                    asm volatile("" ::: "memory");
                }
        } else {
#pragma unroll
            for (int ai = 0; ai < 2; ++ai)
#pragma unroll
                for (int m = 0; m < 4; ++m) {
                    const int row = u.pm * BM + ai * HALF + rowl0 + m * 16;
                    const float r = rs[ai][m] * sc;
#pragma unroll
                    for (int bj = 0; bj < 2; ++bj) {
                        f32x4 a = acc[ai][bj][m][0] * r, b = acc[ai][bj][m][1] * r;
                        if (mode == 1) { a = (f32x4){silu_f(a[0]), silu_f(a[1]), silu_f(a[2]), silu_f(a[3])}; b = (f32x4){silu_f(b[0]), silu_f(b[1]), silu_f(b[2]), silu_f(b[3])}; }
                        u32x4 w; w.x = cvtpk(a[0], a[1]); w.y = cvtpk(a[2], a[3]); w.z = cvtpk(b[0], b[1]); w.w = cvtpk(b[2], b[3]);
                        *(u32x4*)(img + (uni_off(isk, u.pm * BM + ai * HALF + wr * 64 + m * 16, bj, tix, wc, dsh) + loff)) = w;
                    }
                    asm volatile("" ::: "memory");
                }
        }
    }
};
struct EpiVt {
    static constexpr bool PERM = true, AFTER_DRAIN = false;
    bf16_t* O; int F; const float* ss; int dshift;
    __device__ __forceinline__ void operator()(const f32x4 (&acc)[2][2][4][2], const Unit& u, int wr, int wc, int fr, int fq) const {
        float cs[2][8]; const int ls = 14 - dshift;
#pragma unroll
        for (int bj = 0; bj < 2; ++bj) { const int p0 = u.pn * BM + bj * HALF + wc * 32 + 8 * fq, bb = p0 >> 14, rem = p0 & 16383, r = rem >> ls, i0 = rem & ((1 << ls) - 1), tok0 = bb * 16384 + r + (i0 << dshift);
#pragma unroll
            for (int j = 0; j < 8; ++j) cs[bj][j] = __builtin_amdgcn_rsqf(ss[tok0 + (j << dshift)] * (1.0f / 1024.0f) + RMS_EPS_F); }
        const int s2 = fq >> 1, a2 = fq & 1;
#pragma unroll
        for (int ai = 0; ai < 2; ++ai)
#pragma unroll
            for (int m = 0; m < 4; ++m) {
                const int row = u.pm * BM + ai * HALF + wr * 64 + m * 16 + fr;
#pragma unroll
                for (int bj = 0; bj < 2; ++bj) {
                    const f32x4 a = acc[ai][bj][m][0], b = acc[ai][bj][m][1];
                    const int pblk = (u.pn * BM + bj * HALF + wc * 32) >> 5;
                    bf16_t* dst = O + (size_t)pblk * F * 32 + ((((row >> 5) * 2 + s2) * 2) * 32 + (row & 31)) * 8 + 4 * a2;
                    u32x2 w0, w1; w0.x = cvtpk(a[0] * cs[bj][0], a[1] * cs[bj][1]); w0.y = cvtpk(a[2] * cs[bj][2], a[3] * cs[bj][3]); w1.x = cvtpk(b[0] * cs[bj][4], b[1] * cs[bj][5]); w1.y = cvtpk(b[2] * cs[bj][6], b[3] * cs[bj][7]);
                    *(u32x2*)dst = w0; *(u32x2*)(dst + 256) = w1;
                }
            }
    }
};
struct EpiOut0 {
    static constexpr bool PERM = true, AFTER_DRAIN = false;
    const float* res; bf16_t* hb; float* ssn;
    __device__ __forceinline__ void operator()(const f32x4 (&acc)[2][2][4][2], const Unit& u, int wr, int wc, int fr, int fq) const {
#pragma unroll
        for (int ai = 0; ai < 2; ++ai)
#pragma unroll
            for (int m = 0; m < 4; ++m) {
                const int row = u.pm * BM + ai * HALF + wr * 64 + m * 16 + fr; float part = 0.f;
#pragma unroll
                for (int bj = 0; bj < 2; ++bj) {
                    const unsigned off = (unsigned)(row * 1024 + u.pn * BM + bj * HALF + wc * 32 + 8 * fq);
                    const f32x4 a = acc[ai][bj][m][0] + *(const f32x4*)(res + off), b = acc[ai][bj][m][1] + *(const f32x4*)(res + off + 4);
                    part += (a[0] * a[0] + a[1] * a[1]) + (a[2] * a[2] + a[3] * a[3]) + (b[0] * b[0] + b[1] * b[1]) + (b[2] * b[2] + b[3] * b[3]);
                    u32x4 w; w.x = cvtpk(a[0], a[1]); w.y = cvtpk(a[2], a[3]); w.z = cvtpk(b[0], b[1]); w.w = cvtpk(b[2], b[3]);
                    *(u32x4*)(hb + off) = w;
                }
                part += __shfl_xor(part, 16); part += __shfl_xor(part, 32); if (fq == 0) atomicAdd(ssn + row, part);
                asm volatile("" ::: "memory");
            }
    }
};
struct EpiOut1 {
    static constexpr bool PERM = true, AFTER_DRAIN = false;
    const bf16_t* hb; float* out;
    __device__ __forceinline__ void operator()(const f32x4 (&acc)[2][2][4][2], const Unit& u, int wr, int wc, int fr, int fq) const {
#pragma unroll
        for (int ai = 0; ai < 2; ++ai)
#pragma unroll
            for (int m = 0; m < 4; ++m) {
                const int row = u.pm * BM + ai * HALF + wr * 64 + m * 16 + fr;
#pragma unroll
                for (int bj = 0; bj < 2; ++bj) {
                    const unsigned off = (unsigned)(row * 1024 + u.pn * BM + bj * HALF + wc * 32 + 8 * fq);
                    const u32x4 h = *(const u32x4*)(hb + off);
                    f32x4 a = acc[ai][bj][m][0], b = acc[ai][bj][m][1];
                    a[0] += __uint_as_float(h.x << 16); a[1] += __uint_as_float(h.x & 0xffff0000u); a[2] += __uint_as_float(h.y << 16); a[3] += __uint_as_float(h.y & 0xffff0000u);
                    b[0] += __uint_as_float(h.z << 16); b[1] += __uint_as_float(h.z & 0xffff0000u); b[2] += __uint_as_float(h.w << 16); b[3] += __uint_as_float(h.w & 0xffff0000u);
                    *(f32x4*)(out + off) = a; *(f32x4*)(out + off + 4) = b;
                }
                asm volatile("" ::: "memory");
            }
    }
};
template <class Epi, class Sched, bool ALIGN_EPI = false, bool SP2 = false>
__device__ __forceinline__ void gemm_phase(PG8_LAS unsigned char* lds, const Gemm g, const Sched& S, const Epi& E) {
    int tid_ = threadIdx.x; asm volatile("" : "+v"(tid_));
    const int tid = tid_, wid = __builtin_amdgcn_readfirstlane(tid >> 6), lane = tid & 63, wr = wid >> 2, wc = wid & 3, fr = lane & 15, fq = lane >> 4;
    const int K = g.K, nt = K / BK;
    unsigned voffA[2], voffB[2];
#pragma unroll
    for (int i = 0; i < 2; ++i) { int R, C; stage_rc(tid * 16 + i * 8192, R, C); const int Rb = Epi::PERM ? ((R & ~31) + perm32(R & 31)) : R;
        voffA[i] = (unsigned)(R * K + C) * 2u; voffB[i] = (unsigned)(Rb * g.ldb + C) * 2u; }
    const size_t kstep = (size_t)(BK * 2);
    const size_t hstep = (size_t)HALF * K * 2;
    const size_t tstep = 2 * hstep; const size_t hstepB = (size_t)HALF * g.ldb * 2;
    const unsigned ldsw = (unsigned)wid * 1024u;
    const int aoff = lds_byte(wr * 64 + fr, fq * 8), boff = lds_byte(wc * 32 + fr, fq * 8);
#define PG8_SA(b, h) (((b) * 2 + (h)) * HTB)
#define PG8_SB(b, h) ((4 + (b) * 2 + (h)) * HTB)
#define PG8_STAGE(bufoff, gbase, voff) do { _Pragma("unroll") for (int _i = 0; _i < 2; ++_i) \
        __builtin_amdgcn_global_load_lds((const unsigned*)((const char*)(gbase) + (voff)[_i]), (PG8_LAS unsigned*)(lds + (bufoff) + ldsw + _i * 8192), 16, 0, 0); } while (0)
#define PG8_LDA(dst, b, h) do { _Pragma("unroll") for (int m = 0; m < 4; ++m) _Pragma("unroll") for (int k = 0; k < 2; ++k) dst[m][k] = *(const PG8_LAS bf16x8*)(lds + PG8_SA(b, h) + aoff + m * 2048 + k * 1024); } while (0)
#define PG8_LDB(dst, b, h) do { _Pragma("unroll") for (int n = 0; n < 2; ++n) _Pragma("unroll") for (int k = 0; k < 2; ++k) dst[n][k] = *(const PG8_LAS bf16x8*)(lds + PG8_SB(b, h) + boff + n * 2048 + k * 1024); } while (0)
#define PG8_MMA(ai, bj, At, Bt) do { __builtin_amdgcn_s_setprio(1); _Pragma("unroll") for (int m = 0; m < 4; ++m) _Pragma("unroll") for (int n = 0; n < 2; ++n) _Pragma("unroll") for (int k = 0; k < 2; ++k) \
        acc[ai][bj][m][n] = __builtin_amdgcn_mfma_f32_16x16x32_bf16(Bt[n][k], At[m][k], acc[ai][bj][m][n], 0, 0, 0); __builtin_amdgcn_s_setprio(0); } while (0)
#define PG8_WAIT_V(n) asm volatile("s_waitcnt vmcnt(" #n ")" ::: "memory")
#define PG8_WAIT_L(n) asm volatile("s_waitcnt lgkmcnt(" #n ")" ::: "memory")
#define PG8_BAR __builtin_amdgcn_s_barrier()
#define PG8_SCHED __builtin_amdgcn_sched_barrier(0)
    Unit cur, nxt; int ui = 0;
    if (!S.next(0, cur)) return;
    f32x4 acc[2][2][4][2];
#pragma unroll
    for (int a = 0; a < 2; ++a)
#pragma unroll
        for (int b = 0; b < 2; ++b)
#pragma unroll
            for (int m = 0; m < 4; ++m)
#pragma unroll
                for (int n = 0; n < 2; ++n) acc[a][b][m][n] = (f32x4){0.f, 0.f, 0.f, 0.f};
    bf16x8 At[4][2], B0[2][2], B1[2][2];
    const char* cA = (const char*)g.A + (size_t)cur.pm * tstep; const char* cB = b_tile(g, cur.pn);
    S.a_ready(cur);
    if constexpr (SP2) {
        PG8_STAGE(PG8_SB(0, 0), cB, voffB); PG8_STAGE(PG8_SB(0, 1), cB + hstepB, voffB); PG8_STAGE(PG8_SA(0, 0), cA, voffA); PG8_STAGE(PG8_SA(0, 1), cA + hstep, voffA);
        if (wr == 1) PG8_BAR;
        PG8_WAIT_V(2); PG8_BAR;
        PG8_STAGE(PG8_SB(1, 0), cB + kstep, voffB); PG8_STAGE(PG8_SA(1, 0), cA + kstep, voffA); PG8_STAGE(PG8_SB(1, 1), cB + hstepB + kstep, voffB);
        PG8_WAIT_V(6); PG8_BAR;
    } else {
        PG8_STAGE(PG8_SB(0, 0), cB, voffB); PG8_STAGE(PG8_SA(0, 0), cA, voffA); PG8_STAGE(PG8_SB(0, 1), cB + hstepB, voffB); PG8_STAGE(PG8_SA(0, 1), cA + hstep, voffA);
        if (wr == 1) PG8_BAR;
        PG8_WAIT_V(4); PG8_BAR;
        PG8_STAGE(PG8_SB(1, 0), cB + kstep, voffB); PG8_STAGE(PG8_SA(1, 0), cA + kstep, voffA); PG8_STAGE(PG8_SB(1, 1), cB + hstepB + kstep, voffB);
        PG8_WAIT_V(6); PG8_BAR;
    }
    for (;;) {
        const bool has_next = S.next(ui + 1, nxt);
        const char* nA = has_next ? (const char*)g.A + (size_t)nxt.pm * tstep : cA; const char* nB = has_next ? b_tile(g, nxt.pn) : cB;
        for (int t = 0; t < nt; t += 2) {
            const bool last = (t == nt - 2);
            const char* a1 = cA + (size_t)(t + 1) * kstep;
            const char* a2 = last ? nA : cA + (size_t)(t + 2) * kstep; const char* b2 = last ? nB : cB + (size_t)(t + 2) * kstep;
            const char* a3 = a2 + kstep; const char* b3 = b2 + kstep;
            if (last && has_next) S.a_ready(nxt);
            if constexpr (SP2) {
            PG8_LDB(B0, 0, 0); PG8_LDB(B1, 0, 1); PG8_SCHED; PG8_LDA(At, 0, 0); PG8_STAGE(PG8_SA(1, 1), a1 + hstep, voffA);
            PG8_WAIT_V(8); PG8_WAIT_L(0); PG8_BAR; PG8_MMA(0, 0, At, B0); PG8_MMA(0, 1, At, B1); PG8_BAR; PG8_SCHED;
            PG8_LDA(At, 0, 1); PG8_STAGE(PG8_SB(0, 0), b2, voffB); PG8_STAGE(PG8_SB(0, 1), b2 + hstepB, voffB); PG8_STAGE(PG8_SA(0, 0), a2, voffA);
            PG8_WAIT_V(8); PG8_WAIT_L(0); PG8_BAR; PG8_MMA(1, 0, At, B0); PG8_MMA(1, 1, At, B1); PG8_BAR; PG8_SCHED;
            PG8_LDB(B0, 1, 0); PG8_LDB(B1, 1, 1); PG8_SCHED; PG8_LDA(At, 1, 0); PG8_STAGE(PG8_SA(0, 1), a2 + hstep, voffA);
            PG8_WAIT_V(8); PG8_WAIT_L(0); PG8_BAR; PG8_MMA(0, 0, At, B0); PG8_MMA(0, 1, At, B1); PG8_BAR; PG8_SCHED;
            PG8_LDA(At, 1, 1); PG8_STAGE(PG8_SB(1, 0), b3, voffB); PG8_STAGE(PG8_SB(1, 1), b3 + hstepB, voffB); PG8_STAGE(PG8_SA(1, 0), a3, voffA);
            PG8_WAIT_V(8); PG8_WAIT_L(0); PG8_BAR; PG8_MMA(1, 0, At, B0); PG8_MMA(1, 1, At, B1); PG8_BAR; PG8_SCHED;
            } else {
            PG8_LDB(B0, 0, 0); PG8_SCHED; PG8_LDA(At, 0, 0); PG8_STAGE(PG8_SA(1, 1), a1 + hstep, voffA);
            PG8_WAIT_L(8); PG8_BAR; PG8_WAIT_L(0); PG8_MMA(0, 0, At, B0); PG8_BAR; PG8_SCHED;
            PG8_LDB(B1, 0, 1); PG8_STAGE(PG8_SB(0, 0), b2, voffB);
            PG8_BAR; PG8_WAIT_L(0); PG8_MMA(0, 1, At, B1); PG8_BAR;
            PG8_LDA(At, 0, 1); PG8_STAGE(PG8_SA(0, 0), a2, voffA);
            PG8_BAR; PG8_WAIT_L(0); PG8_MMA(1, 0, At, B0); PG8_BAR; PG8_SCHED;
            PG8_STAGE(PG8_SB(0, 1), b2 + hstepB, voffB);
            PG8_WAIT_V(6); PG8_BAR; PG8_MMA(1, 1, At, B1); PG8_BAR;
            PG8_LDB(B0, 1, 0); PG8_SCHED; PG8_LDA(At, 1, 0); PG8_STAGE(PG8_SA(0, 1), a2 + hstep, voffA);
            PG8_WAIT_L(8); PG8_BAR; PG8_WAIT_L(0); PG8_MMA(0, 0, At, B0); PG8_BAR; PG8_SCHED;
            PG8_LDB(B1, 1, 1); PG8_STAGE(PG8_SB(1, 0), b3, voffB);
            PG8_BAR; PG8_WAIT_L(0); PG8_MMA(0, 1, At, B1); PG8_BAR;
            PG8_LDA(At, 1, 1); PG8_STAGE(PG8_SA(1, 0), a3, voffA);
            PG8_BAR; PG8_WAIT_L(0); PG8_MMA(1, 0, At, B0); PG8_BAR; PG8_SCHED;
            PG8_STAGE(PG8_SB(1, 1), b3 + hstepB, voffB);
            PG8_WAIT_V(6); PG8_BAR; PG8_MMA(1, 1, At, B1); PG8_BAR;
            }
        }
        if constexpr (ALIGN_EPI) { if (wr == 0) PG8_BAR; }
        if constexpr (!Epi::AFTER_DRAIN) { E(acc, cur, wr, wc, fr, fq); S.done(cur); }
        if (!has_next) break;
#pragma unroll
        for (int a = 0; a < 2; ++a)
#pragma unroll
            for (int b = 0; b < 2; ++b)
#pragma unroll
                for (int m = 0; m < 4; ++m)
#pragma unroll
                    for (int n = 0; n < 2; ++n) acc[a][b][m][n] = (f32x4){0.f, 0.f, 0.f, 0.f};
        cur = nxt; cA = nA; cB = nB; ++ui;
        if constexpr (ALIGN_EPI) { if (wr == 1) PG8_BAR; }
    }
    PG8_WAIT_V(0);
    if constexpr (!ALIGN_EPI) { if (wr == 0) PG8_BAR; }
    PG8_BAR;
    if constexpr (Epi::AFTER_DRAIN) { E.fused(acc, cur, wr, wc, fr, fq, lds, wid, lane); S.done(cur); }
#undef PG8_SA
#undef PG8_SB
#undef PG8_STAGE
#undef PG8_LDA
#undef PG8_LDB
#undef PG8_MMA
#undef PG8_WAIT_V
#undef PG8_WAIT_L
#undef PG8_BAR
#undef PG8_SCHED
}
}
namespace att {
typedef unsigned short bf16_t;
typedef short bf16x8 __attribute__((ext_vector_type(8)));
typedef short s16x4 __attribute__((ext_vector_type(4)));
typedef float f32x4 __attribute__((ext_vector_type(4)));
typedef float f32x16 __attribute__((ext_vector_type(16)));
typedef unsigned u32x4 __attribute__((ext_vector_type(4)));
typedef unsigned u32x2 __attribute__((ext_vector_type(2)));
using pg8::cvtpk;
constexpr int S = 16384;
constexpr float LOG2E = 1.4426950408889634f;
constexpr float NEG = -1.0e30f;
__device__ __forceinline__ float ex2(float x) { return __builtin_amdgcn_exp2f(x); }
__device__ __forceinline__ float lg2(float x) { return __builtin_amdgcn_logf(x); }
__device__ __forceinline__ float half_max(float v) { const auto rr = __builtin_amdgcn_permlane32_swap(__float_as_uint(v), __float_as_uint(v), false, false); return fmaxf(__uint_as_float(rr[0]), __uint_as_float(rr[1])); }
__device__ __forceinline__ float half_sum(float v) { const auto rr = __builtin_amdgcn_permlane32_swap(__float_as_uint(v), __float_as_uint(v), false, false); return __uint_as_float(rr[0]) + __uint_as_float(rr[1]); }
__device__ __forceinline__ float other_half(float v, int half) { const auto rr = __builtin_amdgcn_permlane32_swap(__float_as_uint(v), __float_as_uint(v), false, false); return half == 0 ? __uint_as_float(rr[1]) : __uint_as_float(rr[0]); }
__device__ __forceinline__ bf16x8 pack8(const f32x16& p, int s2) {
    u32x4 w; w.x = cvtpk(p[8 * s2 + 0], p[8 * s2 + 1]); w.y = cvtpk(p[8 * s2 + 2], p[8 * s2 + 3]); w.z = cvtpk(p[8 * s2 + 4], p[8 * s2 + 5]); w.w = cvtpk(p[8 * s2 + 6], p[8 * s2 + 7]);
    return __builtin_bit_cast(bf16x8, w);
}
__device__ __forceinline__ bf16x8 cat44(s16x4 lo, s16x4 hi) { return (bf16x8){lo[0], lo[1], lo[2], lo[3], hi[0], hi[1], hi[2], hi[3]}; }
#define ATT_ZERO16 (f32x16){0.f,0.f,0.f,0.f,0.f,0.f,0.f,0.f,0.f,0.f,0.f,0.f,0.f,0.f,0.f,0.f}

template <int MODE>
__device__ __forceinline__ void l0_item(int b, int h, int qt, const bf16_t* __restrict__ P0, const bf16_t* __restrict__ KT0, const bf16_t* __restrict__ Vt0, const float* __restrict__ cum, bf16_t* __restrict__ MIX0, float boundN, int lane) {
    const int q = lane & 31, half = lane >> 5, t0 = qt * 32;
    const size_t tokb = (size_t)b * S;
    const int qcol = (MODE == 0 ? 0 : 512) + h * 128, khead = (MODE == 0 ? 0 : 4) + h, vrow = (MODE == 0 ? 0 : 512) + h * 128, ocol = (MODE == 0 ? 0 : 512) + h * 128;
    bf16x8 qf[8];
    { const bf16_t* qp = P0 + (tokb + t0 + q) * 2048 + qcol + 8 * half;
#pragma unroll
      for (int s = 0; s < 8; ++s) qf[s] = *(const bf16x8*)(qp + 16 * s); }
    const float* cb = cum + (size_t)(b * 4 + h) * S;
    float cref = 0.f; int ktmin = 0;
    if (MODE == 0) {
        cref = cb[t0];
        int cnt = 0;
        for (int base = qt - 1; base >= 0; base -= 64) {
            const int kt = base - lane;
            const bool ok = (kt >= 0) && ((cref - cb[(kt < 0 ? 0 : kt) * 32 + 31]) >= -boundN);
            const unsigned long long bal = __ballot(ok);
            const int n = (bal == ~0ull) ? 64 : (__ffsll((unsigned long long)~bal) - 1);
            cnt += n; if (n < 64) break;
        }
        ktmin = qt - cnt;
    }
    f32x16 o[4] = {ATT_ZERO16, ATT_ZERO16, ATT_ZERO16, ATT_ZERO16};
    float mrun = NEG, lrun = 0.f;
    const float thr2 = -boundN * LOG2E;
    bf16x8 kn[8];
    const bf16_t* kbase = KT0 + (size_t)khead * 4096 + half * 256 + q * 8;
    { const bf16_t* kp = kbase + (size_t)((tokb + qt * 32) >> 5) * 32768;
#pragma unroll
      for (int s = 0; s < 8; ++s) kn[s] = *(const bf16x8*)(kp + 512 * s); }
    for (int kt = qt; kt >= ktmin; --kt) {
        const int s0 = kt * 32;
        bf16x8 kf[8];
#pragma unroll
        for (int s = 0; s < 8; ++s) kf[s] = kn[s];
        { const int sn = (kt > 0 ? kt - 1 : 0) * 32;
          const bf16_t* kp = kbase + (size_t)((tokb + sn) >> 5) * 32768;
#pragma unroll
          for (int s = 0; s < 8; ++s) kn[s] = *(const bf16x8*)(kp + 512 * s); }
        f32x4 cv[4];
        if (MODE == 0) {
#pragma unroll
            for (int a = 0; a < 4; ++a) cv[a] = *(const f32x4*)(cb + s0 + 8 * a + 4 * half);
        }
        f32x16 sa = ATT_ZERO16;
        __builtin_amdgcn_s_setprio(1);
#pragma unroll
        for (int s = 0; s < 8; ++s) sa = __builtin_amdgcn_mfma_f32_32x32x16_bf16(kf[s], qf[s], sa, 0, 0, 0);
        __builtin_amdgcn_s_setprio(0);
        bf16x8 vf[4][2];
        { const bf16_t* vp = Vt0 + (size_t)((tokb + s0) >> 5) * 32768 + (vrow >> 5) * 1024 + half * 256 + q * 8;
#pragma unroll
          for (int dt = 0; dt < 4; ++dt)
#pragma unroll
              for (int s2 = 0; s2 < 2; ++s2) vf[dt][s2] = *(const bf16x8*)(vp + dt * 1024 + s2 * 512); }
        f32x16 p;
        if (MODE == 0) {
#pragma unroll
            for (int a = 0; a < 4; ++a)
#pragma unroll
                for (int e = 0; e < 4; ++e) sa[4 * a + e] += (cref - cv[a][e]) * LOG2E;
            if (kt == qt) {
#pragma unroll
                for (int i = 0; i < 16; ++i) { const int key = (i & 3) + 8 * (i >> 2) + 4 * half; if (key > q) sa[i] = NEG; }
            }
            float tm = sa[0];
#pragma unroll
            for (int i = 1; i < 16; ++i) tm = fmaxf(tm, sa[i]);
            tm = half_max(tm);
            const float mn = fmaxf(mrun, tm), alpha = ex2(mrun - mn); mrun = mn;
            float ps = 0.f;
#pragma unroll
            for (int i = 0; i < 16; ++i) { p[i] = ex2(sa[i] - mn); ps += p[i]; }
            ps = half_sum(ps); lrun = lrun * alpha + ps;
#pragma unroll
            for (int dt = 0; dt < 4; ++dt) o[dt] = o[dt] * alpha;
        } else {
            f32x16 l1;
#pragma unroll
            for (int i = 0; i < 16; ++i) { const float z = sa[i], u = lg2(1.0f + ex2(-fabsf(z))), sp = fmaxf(z, 0.f) + u; l1[i] = -sp; p[i] = z - sp; }
            const bool diag = (kt == qt);
            if (diag) {
#pragma unroll
                for (int i = 0; i < 16; ++i) { const int key = (i & 3) + 8 * (i >> 2) + 4 * half; if (key >= q) l1[i] = 0.f; }
            }
            float R[4], ex[16];
#pragma unroll
            for (int a = 0; a < 4; ++a) { ex[4 * a + 3] = 0.f; ex[4 * a + 2] = l1[4 * a + 3]; ex[4 * a + 1] = l1[4 * a + 2] + ex[4 * a + 2]; ex[4 * a + 0] = l1[4 * a + 1] + ex[4 * a + 1]; R[a] = l1[4 * a] + ex[4 * a]; }
            float Ro[4], T[4];
#pragma unroll
            for (int a = 0; a < 4; ++a) { Ro[a] = other_half(R[a], half); T[a] = R[a] + Ro[a]; }
            float suf[4]; suf[3] = 0.f; suf[2] = T[3]; suf[1] = T[2] + suf[2]; suf[0] = T[1] + suf[1];
#pragma unroll
            for (int a = 0; a < 4; ++a) { const float off = lrun + suf[a] + (half == 0 ? Ro[a] : 0.f);
#pragma unroll
                for (int e = 0; e < 4; ++e) p[4 * a + e] = ex2(p[4 * a + e] + off + ex[4 * a + e]); }
            if (diag) {
#pragma unroll
                for (int i = 0; i < 16; ++i) { const int key = (i & 3) + 8 * (i >> 2) + 4 * half; if (key >= q) p[i] = 0.f; }
            }
            lrun += T[0] + suf[0];
        }
        const bf16x8 pb0 = pack8(p, 0), pb1 = pack8(p, 1);
        __builtin_amdgcn_s_setprio(1);
#pragma unroll
        for (int dt = 0; dt < 4; ++dt) { o[dt] = __builtin_amdgcn_mfma_f32_32x32x16_bf16(vf[dt][0], pb0, o[dt], 0, 0, 0); o[dt] = __builtin_amdgcn_mfma_f32_32x32x16_bf16(vf[dt][1], pb1, o[dt], 0, 0, 0); }
        __builtin_amdgcn_s_setprio(0);
        if (MODE == 1) { if (__all(lrun < thr2)) break; }
    }
    const float inv = (MODE == 0) ? __builtin_amdgcn_rcpf(lrun) : 1.0f;
    const bf16_t* gp = P0 + (tokb + t0 + q) * 2048 + 1024 + ocol + 4 * half;
    bf16_t* op = MIX0 + (tokb + t0 + q) * 1024 + ocol + 4 * half;
#pragma unroll
    for (int dt = 0; dt < 4; ++dt)
#pragma unroll
        for (int a = 0; a < 4; ++a) {
            const u32x2 gw = *(const u32x2*)(gp + dt * 32 + 8 * a);
            const float g0 = __uint_as_float(gw.x << 16), g1 = __uint_as_float(gw.x & 0xffff0000u), g2 = __uint_as_float(gw.y << 16), g3 = __uint_as_float(gw.y & 0xffff0000u);
            u32x2 w; w.x = cvtpk(o[dt][4 * a + 0] * inv * g0, o[dt][4 * a + 1] * inv * g1); w.y = cvtpk(o[dt][4 * a + 2] * inv * g2, o[dt][4 * a + 3] * inv * g3);
            *(u32x2*)(op + dt * 32 + 8 * a) = w;
        }
}

template <int MODE>
__device__ __forceinline__ void l0_block(int b, int h, int qb, const bf16_t* __restrict__ P0, const bf16_t* __restrict__ KT0, const bf16_t* __restrict__ Vt0, const float* __restrict__ cum, bf16_t* __restrict__ MIX0, float boundN, PG8_LAS unsigned char* lds, int tid, int wave, int lane) {
    const int qt = qb * 8 + wave;
    const int q = lane & 31, half = lane >> 5, t0 = qt * 32;
    const size_t tokb = (size_t)b * S;
    const int qcol = (MODE == 0 ? 0 : 512) + h * 128, khead = (MODE == 0 ? 0 : 4) + h, vrow = (MODE == 0 ? 0 : 512) + h * 128, ocol = (MODE == 0 ? 0 : 512) + h * 128;
    bf16x8 qf[8];
    { const bf16_t* qp = P0 + (tokb + t0 + q) * 2048 + qcol + 8 * half;
#pragma unroll
      for (int s = 0; s < 8; ++s) qf[s] = *(const bf16x8*)(qp + 16 * s); }
    const float* cb = cum + (size_t)(b * 4 + h) * S;
    float cref = 0.f; int ktmin = 0;
    if (MODE == 0) {
        cref = cb[t0];
        int cnt = 0;
        for (int base = qt - 1; base >= 0; base -= 64) {
            const int kt = base - lane;
            const bool ok = (kt >= 0) && ((cref - cb[(kt < 0 ? 0 : kt) * 32 + 31]) >= -boundN);
            const unsigned long long bal = __ballot(ok);
            const int n = (bal == ~0ull) ? 64 : (__ffsll((unsigned long long)~bal) - 1);
            cnt += n; if (n < 64) break;
        }
        ktmin = qt - cnt;
    }
    f32x16 o[4] = {ATT_ZERO16, ATT_ZERO16, ATT_ZERO16, ATT_ZERO16};
    float mrun = NEG, lrun = 0.f;
    const float thr2 = -boundN * LOG2E;
    constexpr int PBUF = 32768 + 256;
    PG8_LAS int* sh = (PG8_LAS int*)(lds + 2 * PBUF);
    if (lane == 0) sh[wave] = ktmin;
    __syncthreads();
    const int kt_hi = qb * 8 + 7, kt_lo = (MODE == 0) ? sh[0] : 0;
    const int kk_hi = kt_hi >> 1, kk_lo = kt_lo >> 1;
    const bf16_t* ksrc = KT0 + (size_t)khead * 4096 + tid * 8;
    const bf16_t* vsrc = Vt0 + (size_t)(vrow >> 5) * 1024 + tid * 8;
    const int kb0 = (int)(tokb >> 5);
    { const size_t o0 = (size_t)(kb0 + 2 * kk_hi) * 32768, o1 = o0 + 32768;
      const u32x4 k0 = *(const u32x4*)(ksrc + o0), v0 = *(const u32x4*)(vsrc + o0), k1 = *(const u32x4*)(ksrc + o1), v1 = *(const u32x4*)(vsrc + o1);
      *(PG8_LAS u32x4*)(lds + tid * 16) = k0; *(PG8_LAS u32x4*)(lds + 8192 + tid * 16) = v0; *(PG8_LAS u32x4*)(lds + 16384 + tid * 16) = k1; *(PG8_LAS u32x4*)(lds + 24576 + tid * 16) = v1;
      if (MODE == 0 && tid < 16) *(PG8_LAS f32x4*)(lds + 32768 + tid * 16) = *(const f32x4*)(cb + kk_hi * 64 + tid * 4); }
    __syncthreads();
    bool done = false;
    int cur = 0;
    for (int kk = kk_hi; kk >= kk_lo; --kk, cur ^= 1) {
        const int kkn = kk > kk_lo ? kk - 1 : kk_lo;
        const size_t on0 = (size_t)(kb0 + 2 * kkn) * 32768, on1 = on0 + 32768;
        const u32x4 kpre0 = *(const u32x4*)(ksrc + on0), vpre0 = *(const u32x4*)(vsrc + on0), kpre1 = *(const u32x4*)(ksrc + on1), vpre1 = *(const u32x4*)(vsrc + on1);
        f32x4 bpre = {0.f, 0.f, 0.f, 0.f};
        if (MODE == 0 && tid < 16) bpre = *(const f32x4*)(cb + kkn * 64 + tid * 4);
        PG8_LAS unsigned char* bufp = lds + cur * PBUF;
#pragma unroll 1
        for (int sub = 1; sub >= 0; --sub) {
        const int kt = 2 * kk + sub;
        PG8_LAS unsigned char* bufc = bufp + sub * 16384;
        if (kt <= qt && kt >= ktmin && !done) {
        const int s0 = kt * 32; (void)s0;
        f32x4 cv[4];
        if (MODE == 0) {
#pragma unroll
            for (int a = 0; a < 4; ++a) cv[a] = *(const PG8_LAS f32x4*)(bufp + 32768 + sub * 128 + (8 * a + 4 * half) * 4);
        }
        bf16x8 kf[8];
#pragma unroll
        for (int s = 0; s < 8; ++s) kf[s] = *(const PG8_LAS bf16x8*)(bufc + s * 1024 + half * 512 + q * 16);
        f32x16 sa = ATT_ZERO16;
        __builtin_amdgcn_s_setprio(1);
#pragma unroll
        for (int s = 0; s < 8; ++s) sa = __builtin_amdgcn_mfma_f32_32x32x16_bf16(kf[s], qf[s], sa, 0, 0, 0);
        __builtin_amdgcn_s_setprio(0);
        bf16x8 vf[4][2];
#pragma unroll
        for (int dt = 0; dt < 4; ++dt)
#pragma unroll
            for (int s2 = 0; s2 < 2; ++s2) vf[dt][s2] = *(const PG8_LAS bf16x8*)(bufc + 8192 + dt * 2048 + s2 * 1024 + half * 512 + q * 16);
        f32x16 p;
        if (MODE == 0) {
#pragma unroll
            for (int a = 0; a < 4; ++a)
#pragma unroll
                for (int e = 0; e < 4; ++e) sa[4 * a + e] += (cref - cv[a][e]) * LOG2E;
            if (kt == qt) {
#pragma unroll
                for (int i = 0; i < 16; ++i) { const int key = (i & 3) + 8 * (i >> 2) + 4 * half; if (key > q) sa[i] = NEG; }
            }
            float tm = sa[0];
#pragma unroll
            for (int i = 1; i < 16; ++i) tm = fmaxf(tm, sa[i]);
            tm = half_max(tm);
            const float mn = fmaxf(mrun, tm);
            if (!__all(mn == mrun)) {
                const float alpha = ex2(mrun - mn); mrun = mn; lrun *= alpha;
#pragma unroll
                for (int dt = 0; dt < 4; ++dt) o[dt] = o[dt] * alpha;
            }
            float ps = 0.f;
#pragma unroll
            for (int i = 0; i < 16; ++i) { p[i] = ex2(sa[i] - mrun); ps += p[i]; }
            ps = half_sum(ps); lrun += ps;
        } else {
            f32x16 l1;
#pragma unroll
            for (int i = 0; i < 16; ++i) { const float z = sa[i], u = lg2(1.0f + ex2(-fabsf(z))), sp = fmaxf(z, 0.f) + u; l1[i] = -sp; p[i] = z - sp; }
            const bool diag = (kt == qt);
            if (diag) {
#pragma unroll
                for (int i = 0; i < 16; ++i) { const int key = (i & 3) + 8 * (i >> 2) + 4 * half; if (key >= q) l1[i] = 0.f; }
            }
            float R[4], ex[16];
#pragma unroll
            for (int a = 0; a < 4; ++a) { ex[4 * a + 3] = 0.f; ex[4 * a + 2] = l1[4 * a + 3]; ex[4 * a + 1] = l1[4 * a + 2] + ex[4 * a + 2]; ex[4 * a + 0] = l1[4 * a + 1] + ex[4 * a + 1]; R[a] = l1[4 * a] + ex[4 * a]; }
            float Ro[4], T[4];
#pragma unroll
            for (int a = 0; a < 4; ++a) { Ro[a] = other_half(R[a], half); T[a] = R[a] + Ro[a]; }
            float suf[4]; suf[3] = 0.f; suf[2] = T[3]; suf[1] = T[2] + suf[2]; suf[0] = T[1] + suf[1];
#pragma unroll
            for (int a = 0; a < 4; ++a) { const float off = lrun + suf[a] + (half == 0 ? Ro[a] : 0.f);
#pragma unroll
                for (int e = 0; e < 4; ++e) p[4 * a + e] = ex2(p[4 * a + e] + off + ex[4 * a + e]); }
            if (diag) {
#pragma unroll
                for (int i = 0; i < 16; ++i) { const int key = (i & 3) + 8 * (i >> 2) + 4 * half; if (key >= q) p[i] = 0.f; }
            }
            lrun += T[0] + suf[0];
        }
        const bf16x8 pb0 = pack8(p, 0), pb1 = pack8(p, 1);
        __builtin_amdgcn_s_setprio(1);
#pragma unroll
        for (int dt = 0; dt < 4; ++dt) { o[dt] = __builtin_amdgcn_mfma_f32_32x32x16_bf16(vf[dt][0], pb0, o[dt], 0, 0, 0); o[dt] = __builtin_amdgcn_mfma_f32_32x32x16_bf16(vf[dt][1], pb1, o[dt], 0, 0, 0); }
        __builtin_amdgcn_s_setprio(0);
        if (MODE == 1) { if (__all(lrun < thr2)) done = true; }
        }
        }
        { PG8_LAS unsigned char* bn = lds + (cur ^ 1) * PBUF;
          *(PG8_LAS u32x4*)(bn + tid * 16) = kpre0; *(PG8_LAS u32x4*)(bn + 8192 + tid * 16) = vpre0; *(PG8_LAS u32x4*)(bn + 16384 + tid * 16) = kpre1; *(PG8_LAS u32x4*)(bn + 24576 + tid * 16) = vpre1;
          if (MODE == 0 && tid < 16) *(PG8_LAS f32x4*)(bn + 32768 + tid * 16) = bpre; }
        if (MODE == 1) { if (__syncthreads_and(done ? 1 : 0)) break; }
        else __syncthreads();
    }
    const float inv = (MODE == 0) ? __builtin_amdgcn_rcpf(lrun) : 1.0f;
    const bf16_t* gp = P0 + (tokb + t0 + q) * 2048 + 1024 + ocol + 4 * half;
    bf16_t* op = MIX0 + (tokb + t0 + q) * 1024 + ocol + 4 * half;
#pragma unroll
    for (int dt = 0; dt < 4; ++dt)
#pragma unroll
        for (int a = 0; a < 4; ++a) {
            const u32x2 gw = *(const u32x2*)(gp + dt * 32 + 8 * a);
            const float g0 = __uint_as_float(gw.x << 16), g1 = __uint_as_float(gw.x & 0xffff0000u), g2 = __uint_as_float(gw.y << 16), g3 = __uint_as_float(gw.y & 0xffff0000u);
            u32x2 w; w.x = cvtpk(o[dt][4 * a + 0] * inv * g0, o[dt][4 * a + 1] * inv * g1); w.y = cvtpk(o[dt][4 * a + 2] * inv * g2, o[dt][4 * a + 3] * inv * g3);
            *(u32x2*)(op + dt * 32 + 8 * a) = w;
        }
}

__device__ __forceinline__ void dil_tile(int g, int dshift, int b, int h, int r, int i0, int nq, int T0, const bf16_t* __restrict__ P1, const bf16_t* __restrict__ KT1, const bf16_t* __restrict__ Vt1, float slope2, PG8_LAS bf16_t* og, PG8_LAS float* lse, int lane, float skip2) {
    const int qraw = lane & 31, half = lane >> 5, q = qraw < nq ? qraw : nq - 1;
    const int dil = 1 << dshift, L = S >> dshift;
    const size_t tokb = (size_t)b * S;
    const int iq = i0 + q, tq = (iq << dshift) + r;
    bf16x8 qf[4];
    { const size_t pq = tokb + (size_t)r * L + i0;
      const bf16_t* qp = P1 + (size_t)(pq >> 5) * 49152 + (size_t)(g * 8 + h) * 2048 + half * 256 + ((int)(pq & 31) + q) * 8;
#pragma unroll
      for (int s = 0; s < 4; ++s) qf[s] = *(const bf16x8*)(qp + 512 * s); }
    f32x16 o[2] = {ATT_ZERO16, ATT_ZERO16};
    float mrun = NEG, lrun = 0.f;
    const float sl = slope2 * (float)dil;
    const int d0i = iq - (i0 & ~31) + 128 - 4 * half; const float t0a = -sl * (float)d0i;
    const int ib = i0 & ~31;
    const bf16_t* kbase = KT1 + (size_t)(g * 8 + h) * 2048 + half * 256 + qraw * 8;
    const size_t pb0 = tokb + (size_t)r * L;
    bf16x8 kn[4];
    { const bf16_t* kp = kbase + (size_t)((pb0 + ib) >> 5) * 49152;
#pragma unroll
      for (int s = 0; s < 4; ++s) kn[s] = *(const bf16x8*)(kp + 512 * s); }
    for (int kt = 4; kt >= 0; --kt) {
        const int j0 = ib - 128 + 32 * kt;
        if (j0 < 0) break;
        if (sl * (float)((i0 - ib) + 97 - 32 * kt) > skip2) break;
        bf16x8 kf[4];
#pragma unroll
        for (int s = 0; s < 4; ++s) kf[s] = kn[s];
        { const int jn = j0 >= 32 ? j0 - 32 : 0;
          const bf16_t* kp = kbase + (size_t)((pb0 + jn) >> 5) * 49152;
#pragma unroll
          for (int s = 0; s < 4; ++s) kn[s] = *(const bf16x8*)(kp + 512 * s); }
        f32x16 sa;
        { const float base = t0a + sl * (float)(32 * kt);
#pragma unroll
          for (int i = 0; i < 16; ++i) sa[i] = base + sl * (float)((i & 3) + 8 * (i >> 2)); }
        __builtin_amdgcn_s_setprio(1);
#pragma unroll
        for (int s = 0; s < 4; ++s) sa = __builtin_amdgcn_mfma_f32_32x32x16_bf16(kf[s], qf[s], sa, 0, 0, 0);
        __builtin_amdgcn_s_setprio(0);
        bf16x8 vf[2][2];
        { const bf16_t* vp = Vt1 + (size_t)g * 512 * 32768 + (size_t)((pb0 + j0) >> 5) * 16384 + (h * 2) * 1024 + half * 256 + qraw * 8;
#pragma unroll
          for (int dt = 0; dt < 2; ++dt)
#pragma unroll
              for (int s2 = 0; s2 < 2; ++s2) vf[dt][s2] = *(const bf16x8*)(vp + dt * 1024 + s2 * 512); }
        { const int dmin = (i0 - ib) + 97 - 32 * kt, dmax = (i0 - ib) + nq + 127 - 32 * kt;
          if (dmin < 0 || dmax > 128) {
#pragma unroll
              for (int i = 0; i < 16; ++i) { const int dist = d0i - 32 * kt - ((i & 3) + 8 * (i >> 2)); if ((unsigned)dist > 128u) sa[i] = NEG; }
          } }
        float tm = sa[0];
#pragma unroll
        for (int i = 1; i < 16; ++i) tm = fmaxf(tm, sa[i]);
        tm = half_max(tm);
        const float mn = fmaxf(mrun, tm), alpha = ex2(mrun - mn); mrun = mn;
        f32x16 p; float ps = 0.f;
#pragma unroll
        for (int i = 0; i < 16; ++i) { p[i] = ex2(sa[i] - mn); ps += p[i]; }
        ps = half_sum(ps); lrun = lrun * alpha + ps;
        o[0] = o[0] * alpha; o[1] = o[1] * alpha;
        const bf16x8 pb0 = pack8(p, 0), pb1 = pack8(p, 1);
        __builtin_amdgcn_s_setprio(1);
#pragma unroll
        for (int dt = 0; dt < 2; ++dt) { o[dt] = __builtin_amdgcn_mfma_f32_32x32x16_bf16(vf[dt][0], pb0, o[dt], 0, 0, 0); o[dt] = __builtin_amdgcn_mfma_f32_32x32x16_bf16(vf[dt][1], pb1, o[dt], 0, 0, 0); }
        __builtin_amdgcn_s_setprio(0);
    }
    if (qraw < nq) {
        const float inv = __builtin_amdgcn_rcpf(lrun); const int tl = tq - T0;
        if (half == 0) lse[tl] = mrun + lg2(lrun);
        PG8_LAS bf16_t* dst = og + (size_t)tl * 64 + 4 * half;
#pragma unroll
        for (int dt = 0; dt < 2; ++dt)
#pragma unroll
            for (int a = 0; a < 4; ++a) { u32x2 w; w.x = cvtpk(o[dt][4 * a + 0] * inv, o[dt][4 * a + 1] * inv); w.y = cvtpk(o[dt][4 * a + 2] * inv, o[dt][4 * a + 3] * inv);
                *(PG8_LAS u32x2*)(dst + dt * 32 + 8 * a) = w; }
    }
}
}
#ifndef PH_MASK
#define PH_MASK 127
#endif
#ifndef WGM_P1
#define WGM_P1 4
#endif
#ifndef WGM_P4
#define WGM_P4 2
#endif
#ifndef REP0
#define REP0 1
#endif
#ifndef REP1
#define REP1 1
#endif
#ifndef REP3
#define REP3 1
#endif
#ifndef REP4
#define REP4 1
#endif
#ifndef REP6
#define REP6 1
#endif
#ifndef REP2
#define REP2 1
#endif
#ifndef REP5
#define REP5 1
#endif
#define LAS __attribute__((address_space(3)))
#define GAS __attribute__((address_space(1)))
typedef unsigned short bf16;
constexpr int NB = 2, SEQ = 16384, MTOK = NB * SEQ, DM = 1024;
constexpr int EVEN_IN = 4100, ODD_IN = 5120;
constexpr size_t MiB = 1u << 20;
constexpr size_t WS_CTL = 0;
constexpr size_t WS_W0T = 2 * MiB;
constexpr size_t WS_W0VT = 8 * MiB;
constexpr size_t WS_W0O = 10 * MiB;
constexpr size_t WS_W1T = 12 * MiB;
constexpr size_t WS_W1VT = 19 * MiB;
constexpr size_t WS_W1O = 22 * MiB;
constexpr size_t WS_SS0 = 24 * MiB, WS_SS1 = WS_SS0 + 131072, WS_LOGF = WS_SS1 + 131072, WS_CUM = WS_LOGF + 524288;
constexpr size_t WS_XB = 32 * MiB;
constexpr size_t WS_P = 96 * MiB;
constexpr size_t WS_KT = 224 * MiB;
constexpr size_t WS_VT0 = 320 * MiB, WS_MIX0 = 384 * MiB;
constexpr size_t WS_VT1 = 320 * MiB;
constexpr size_t WS_MIX1 = 448 * MiB;
constexpr size_t WS_END = 480 * MiB;
constexpr int LDS_BYTES = 148480, EPI_SCR_OFF = 131072, MISC_OFF = 147456;
constexpr int CW_BAR = 4096;

#define XB_TMO      128
#define XB_XCNT(j)  (256  + 64 * (j))
#define XB_XSUB(j)  (1280 + 64 * (j))
#define XB_XGEN(j)  (2304 + 64 * (j))
#define XB_TOP      3328
#define XB_TOPGEN   3392
#define XCD_BAR_WORDS 3456
#define XB_SPIN_CAP (1u << 18)

__device__ __forceinline__ unsigned xb_ld(unsigned* p)              { return __hip_atomic_load(p, __ATOMIC_RELAXED, __HIP_MEMORY_SCOPE_AGENT); }
__device__ __forceinline__ unsigned xb_add(unsigned* p, unsigned v) { return __hip_atomic_fetch_add(p, v, __ATOMIC_RELAXED, __HIP_MEMORY_SCOPE_AGENT); }
__device__ __forceinline__ unsigned xb_xcc_id() { return (unsigned)__builtin_amdgcn_s_getreg((3 << 11) | 20) & 0xFu; }
#define XB_SPIN(cond, bar) do { unsigned _sp = 0; while (cond) { __builtin_amdgcn_s_sleep(1); \
    if ((++_sp & 255u) == 0u) { if (xb_ld(&(bar)[XB_TMO])) break; if (_sp > XB_SPIN_CAP) { atomicAdd(&(bar)[XB_TMO], 1u); break; } } } } while (0)

struct XcdBarrier {
    unsigned* bar; unsigned x;
    volatile LAS unsigned* st;
};

__device__ __forceinline__ XcdBarrier xcd_barrier_post(unsigned* bar, volatile LAS unsigned* st) {
    XcdBarrier b; b.bar = bar; b.x = xb_xcc_id(); b.st = st;
    if (threadIdx.x == 0) (void)xb_add(&bar[XB_XCNT(b.x)], 1u);
    return b;
}
__device__ __forceinline__ void xcd_barrier_complete(unsigned* bar, unsigned x, unsigned& nloc, unsigned& nx) {
    const unsigned G = gridDim.x * gridDim.y * gridDim.z;
    unsigned sum, cnt, mine, sp = 0u;
    for (;;) {
        sum = 0u; cnt = 0u; mine = 0u;
#pragma unroll
        for (unsigned j = 0; j < 16; ++j) { const unsigned c = xb_ld(&bar[XB_XCNT(j)]); sum += c; cnt += (c > 0u) ? 1u : 0u; mine = (j == x) ? c : mine; }
        if (sum == G) break;
        __builtin_amdgcn_s_sleep(1);
        if ((++sp & 255u) == 0u) { if (xb_ld(&bar[XB_TMO])) break; if (sp > XB_SPIN_CAP) { atomicAdd(&bar[XB_TMO], 1u); break; } }
    }
    nloc = mine > 0u ? mine : 1u; nx = cnt > 0u ? cnt : 1u;
}

__device__ __forceinline__ void xcd_barrier(const XcdBarrier& b) {
    asm volatile("s_waitcnt vmcnt(0)" ::: "memory");
    __syncthreads();
    if (threadIdx.x == 0) {
        unsigned* bar = b.bar;
        __builtin_amdgcn_s_waitcnt(0);
        unsigned nloc = b.st[0], nx = b.st[1];
        if (nloc == 0u) { xcd_barrier_complete(bar, b.x, nloc, nx); b.st[0] = nloc; b.st[1] = nx; }
        const unsigned old = xb_add(&bar[XB_XSUB(b.x)], 1u);
        const unsigned gen = old / nloc;
        if (old + 1u == (gen + 1u) * nloc) {
            __builtin_amdgcn_fence(__ATOMIC_RELEASE, "agent");
            asm volatile("s_waitcnt vmcnt(0)" ::: "memory");
            const unsigned og = xb_add(&bar[XB_TOP], 1u);
            const unsigned tg = og / nx;
            if (og + 1u == (tg + 1u) * nx) xb_add(&bar[XB_TOPGEN], 1u);
            else XB_SPIN(xb_ld(&bar[XB_TOPGEN]) == tg, bar);
            __builtin_amdgcn_fence(__ATOMIC_ACQUIRE, "agent");
            xb_add(&bar[XB_XGEN(b.x)], 1u);
            asm volatile("s_waitcnt vmcnt(0)" ::: "memory");
        } else {
            XB_SPIN(xb_ld(&bar[XB_XGEN(b.x)]) == gen, bar);
            __builtin_amdgcn_fence(__ATOMIC_ACQUIRE, "agent");
            asm volatile("s_waitcnt vmcnt(0)" ::: "memory");
        }
    }
    __syncthreads();
}

__device__ __forceinline__ float wave_sum(float v) {
#pragma unroll
    for (int o = 1; o < 64; o <<= 1) v += __shfl_xor(v, o);
    return v;
}
__device__ __forceinline__ float wave_max(float v) {
#pragma unroll
    for (int o = 1; o < 64; o <<= 1) v = fmaxf(v, __shfl_xor(v, o));
    return v;
}
struct TItem { const float* W; const float* gain; bf16* WT; int ldw, c0, K, row_off, nblk, r; };
__device__ __forceinline__ void titem_load(const TItem& t, int lane, pg8::f32x4 (&v)[8], float (&gv)[8]) {
    const int kb = t.r / t.nblk, nb = t.r % t.nblk, k0 = 64 * kb, n0 = 32 * nb;
#pragma unroll
    for (int i = 0; i < 8; ++i) { const int kk = (lane >> 3) + 8 * i; v[i] = *(const pg8::f32x4*)(t.W + (size_t)(k0 + kk) * t.ldw + t.c0 + n0 + 4 * (lane & 7)); gv[i] = t.gain ? t.gain[k0 + kk] : 1.0f; }
}
__device__ __forceinline__ void titem_store(const TItem& t, int lane, const pg8::f32x4 (&v)[8], const float (&gv)[8], LAS float* scr) {
    const int kb = t.r / t.nblk, nb = t.r % t.nblk, k0 = 64 * kb, n0 = 32 * nb;
#pragma unroll
    for (int i = 0; i < 8; ++i) { const int kk = (lane >> 3) + 8 * i; LAS float* d = scr + kk * 33 + 4 * (lane & 7); d[0] = v[i][0] * gv[i]; d[1] = v[i][1] * gv[i]; d[2] = v[i][2] * gv[i]; d[3] = v[i][3] * gv[i]; }
    asm volatile("s_waitcnt lgkmcnt(0)" ::: "memory");
    const int c = lane & 7;
#pragma unroll
    for (int j = 0; j < 4; ++j) { const int n = (lane >> 3) + 8 * j; const LAS float* s = scr + (8 * c) * 33 + n;
        pg8::u32x4 o; o.x = pg8::cvtpk(s[0 * 33], s[1 * 33]); o.y = pg8::cvtpk(s[2 * 33], s[3 * 33]); o.z = pg8::cvtpk(s[4 * 33], s[5 * 33]); o.w = pg8::cvtpk(s[6 * 33], s[7 * 33]);
        *(pg8::u32x4*)(t.WT + (size_t)(t.row_off + n0 + n) * t.K + k0 + 8 * c) = o; }
    asm volatile("s_waitcnt lgkmcnt(0)" ::: "memory");
}

struct Args { const float* in[12]; float* out; unsigned char* ws; };

__global__ void __launch_bounds__(512, 2) mk_fwd(Args args) {
    extern __shared__ __attribute__((aligned(16))) unsigned char lds_raw[];
    cg::grid_group grid = cg::this_grid();
    LAS unsigned char* lds = (LAS unsigned char*)lds_raw;
    const int wave = __builtin_amdgcn_readfirstlane((int)threadIdx.x >> 6);
#define PHASE_IDS int tid = threadIdx.x; asm volatile("" : "+v"(tid)); const int lane = tid & 63; (void)lane; PHASE_PTRS
    const int G = gridDim.x, gw = blockIdx.x * 8 + wave, NGW = G * 8;
#define PHASE_PTRS const __attribute__((address_space(4))) Args* ap_ = (const __attribute__((address_space(4))) Args*)__builtin_amdgcn_kernarg_segment_ptr(); asm volatile("" : "+s"(ap_)); unsigned char* ws = ap_->ws; const float* x = ap_->in[0]; const float* even_norm = ap_->in[1]; const float* even_w_in = ap_->in[2]; const float* even_b_f = ap_->in[3]; const float* even_qg = ap_->in[4]; const float* even_kg = ap_->in[5]; const float* even_w_out = ap_->in[6]; const float* odd_norm = ap_->in[7]; const float* odd_w_in = ap_->in[8]; const float* odd_qg = ap_->in[9]; const float* odd_kg = ap_->in[10]; const float* odd_w_out = ap_->in[11]; float* out = ap_->out; bf16* W0T = (bf16*)(ws + WS_W0T); bf16* W0VT = (bf16*)(ws + WS_W0VT); bf16* W0O = (bf16*)(ws + WS_W0O); bf16* W1T = (bf16*)(ws + WS_W1T); bf16* W1VT = (bf16*)(ws + WS_W1VT); bf16* W1O = (bf16*)(ws + WS_W1O); float* SS0 = (float*)(ws + WS_SS0); float* SS1 = (float*)(ws + WS_SS1); float* LOGF = (float*)(ws + WS_LOGF); float* CUM = (float*)(ws + WS_CUM); bf16* XB = (bf16*)(ws + WS_XB); bf16* PB = (bf16*)(ws + WS_P); bf16* KT = (bf16*)(ws + WS_KT); bf16* VT0 = (bf16*)(ws + WS_VT0); bf16* MIX0 = (bf16*)(ws + WS_MIX0); bf16* VT1 = (bf16*)(ws + WS_VT1); bf16* MIX1 = (bf16*)(ws + WS_MIX1); unsigned* CTL = (unsigned*)(ws + WS_CTL);
    { PHASE_IDS
    if (tid < 64) ((volatile LAS unsigned*)(lds + MISC_OFF))[tid] = 0u;
    __syncthreads();
    if (blockIdx.x == 0) {
#pragma unroll
        for (int k = 0; k < 16; ++k) CTL[tid + 512 * k] = 0u;
    }
    }
#define XBAR() do { XcdBarrier b_; b_.bar = (unsigned*)(args.ws + WS_CTL) + CW_BAR; b_.x = xb_xcc_id(); b_.st = (volatile LAS unsigned*)(lds + MISC_OFF); xcd_barrier(b_); } while (0)

#if PH_MASK & 1
    { PHASE_IDS
#if REP0 > 1
      for (int rep0 = 0; rep0 < REP0; ++rep0) { if (rep0) __syncthreads();
#else
      {
#endif
        LAS float* scr = (LAS float*)(lds + wave * 16384);
        LAS float* gwf = (LAS float*)(lds + 131072);
        for (int k = tid; k < 1024; k += 512) { const pg8::f32x4 w = *(const pg8::f32x4*)(even_w_in + (size_t)k * EVEN_IN + 1536); const float gk = even_norm[k];
            *(LAS pg8::f32x4*)(gwf + 4 * k) = w * gk; }
        constexpr int I512 = 16 * 16, I1024 = 16 * 32, I1536 = 16 * 48, IO1 = 8 * 32;
        constexpr int NITEMS = 6 * I512 + I1024   + I1024   + 3 * I1536 + I512   + IO1;
        auto decode = [&](int it) -> TItem {
            int r = it;
            if (r < I512) return TItem{even_w_in, even_norm, W0T, EVEN_IN, 0, 1024, 0, 16, r}; r -= I512;
            if (r < I512) return TItem{even_w_in, even_norm, W0T, EVEN_IN, 512, 1024, 512, 16, r}; r -= I512;
            if (r < I512) return TItem{even_w_in, even_norm, W0T, EVEN_IN, 1540, 1024, 1024, 16, r}; r -= I512;
            if (r < I512) return TItem{even_w_in, even_norm, W0T, EVEN_IN, 2052, 1024, 1536, 16, r}; r -= I512;
            if (r < I1024) return TItem{even_w_in, even_norm, W0T, EVEN_IN, 3076, 1024, 2048, 32, r}; r -= I1024;
            if (r < I512) return TItem{even_w_in, even_norm, W0VT, EVEN_IN, 1024, 1024, 0, 16, r}; r -= I512;
            if (r < I512) return TItem{even_w_in, even_norm, W0VT, EVEN_IN, 2564, 1024, 512, 16, r}; r -= I512;
            if (r < I1024) return TItem{even_w_out, nullptr, W0O, 1024, 0, 1024, 0, 32, r}; r -= I1024;
            if (r < I1536) return TItem{odd_w_in, odd_norm, W1T, ODD_IN, 0, 1024, 0, 48, r}; r -= I1536;
            if (r < I1536) return TItem{odd_w_in, odd_norm, W1T, ODD_IN, 1536, 1024, 1536, 48, r}; r -= I1536;
            if (r < I512) return TItem{odd_w_in, odd_norm, W1T, ODD_IN, 4608, 1024, 3072, 16, r}; r -= I512;
            if (r < I1536) return TItem{odd_w_in, odd_norm, W1VT, ODD_IN, 3072, 1024, 0, 48, r}; r -= I1536;
            return TItem{odd_w_out, nullptr, W1O, 1024, 0, 512, 0, 32, r};
        };
        for (int it = gw; it < NITEMS; it += 3 * NGW) {
            const int it1 = it + NGW, it2 = it + 2 * NGW; const bool h1 = it1 < NITEMS, h2 = it2 < NITEMS;
            const TItem t0 = decode(it), t1 = decode(h1 ? it1 : it), t2 = decode(h2 ? it2 : it);
            pg8::f32x4 v0[8], v1[8], v2[8]; float g0[8], g1[8], g2[8];
            titem_load(t0, lane, v0, g0);
            if (h1) titem_load(t1, lane, v1, g1);
            if (h2) titem_load(t2, lane, v2, g2);
            titem_store(t0, lane, v0, g0, scr);
            if (h1) titem_store(t1, lane, v1, g1, scr);
            if (h2) titem_store(t2, lane, v2, g2, scr);
        }
        for (int i = blockIdx.x * 512 + tid; i < MTOK; i += G * 512) SS1[i] = 0.f;
        __syncthreads();
        const float bf0 = even_b_f[0], bf1 = even_b_f[1], bf2 = even_b_f[2], bf3 = even_b_f[3];
        LAS float* lf = (LAS float*)(lds + wave * 16384 + 12288);
        for (int ck = blockIdx.x; ck < MTOK / 128; ck += G) {
            pg8::f32x4 vn[4][4];
#pragma unroll
            for (int q = 0; q < 4; ++q)
#pragma unroll
                for (int j = 0; j < 4; ++j) vn[q][j] = ((const pg8::f32x4*)(x + (size_t)(ck * 128 + wave * 16 + q) * DM) + lane)[64 * j];
#pragma unroll 1
            for (int r4 = 0; r4 < 16; r4 += 4) {
                const int m0 = ck * 128 + wave * 16 + r4;
                pg8::f32x4 v[4][4];
#pragma unroll
                for (int q = 0; q < 4; ++q)
#pragma unroll
                    for (int j = 0; j < 4; ++j) v[q][j] = vn[q][j];
                { const int mn = ck * 128 + wave * 16 + (r4 < 12 ? r4 + 4 : 12);
#pragma unroll
                  for (int q = 0; q < 4; ++q)
#pragma unroll
                      for (int j = 0; j < 4; ++j) vn[q][j] = ((const pg8::f32x4*)(x + (size_t)(mn + q) * DM) + lane)[64 * j]; }
                float s[4] = {0.f, 0.f, 0.f, 0.f}, d[4][4] = {{0.f, 0.f, 0.f, 0.f}, {0.f, 0.f, 0.f, 0.f}, {0.f, 0.f, 0.f, 0.f}, {0.f, 0.f, 0.f, 0.f}};
#pragma unroll
                for (int j = 0; j < 4; ++j) {
#pragma unroll
                    for (int e = 0; e < 4; ++e) { const pg8::f32x4 w = *(const LAS pg8::f32x4*)(gwf + 4 * (256 * j + 4 * lane + e));
#pragma unroll
                        for (int q = 0; q < 4; ++q) { const float xv = v[q][j][e]; s[q] += xv * xv; d[q][0] += xv * w[0]; d[q][1] += xv * w[1]; d[q][2] += xv * w[2]; d[q][3] += xv * w[3]; } }
#pragma unroll
                    for (int q = 0; q < 4; ++q) ((unsigned long long*)(XB + (size_t)(m0 + q) * DM) + lane)[64 * j] = (unsigned long long)pg8::cvtpk(v[q][j][0], v[q][j][1]) | ((unsigned long long)pg8::cvtpk(v[q][j][2], v[q][j][3]) << 32);
                }
#pragma unroll
                for (int o = 1; o < 64; o <<= 1) {
#pragma unroll
                    for (int q = 0; q < 4; ++q) { s[q] += __shfl_xor(s[q], o); d[q][0] += __shfl_xor(d[q][0], o); d[q][1] += __shfl_xor(d[q][1], o); d[q][2] += __shfl_xor(d[q][2], o); d[q][3] += __shfl_xor(d[q][3], o); } }
                if (lane < 4) {
                    const float sq = lane == 0 ? s[0] : (lane == 1 ? s[1] : (lane == 2 ? s[2] : s[3]));
                    float dd[4];
#pragma unroll
                    for (int hh = 0; hh < 4; ++hh) dd[hh] = lane == 0 ? d[0][hh] : (lane == 1 ? d[1][hh] : (lane == 2 ? d[2][hh] : d[3][hh]));
                    SS0[m0 + lane] = sq;
                    const float rr = 1.0f / sqrtf(sq * (1.0f / 1024.0f) + 1e-6f);
                    const float f0 = rr * dd[0] + bf0, f1 = rr * dd[1] + bf1, f2 = rr * dd[2] + bf2, f3 = rr * dd[3] + bf3;
                    lf[(r4 + lane) * 4 + 0] = fminf(f0, 0.f) - log1pf(expf(-fabsf(f0)));
                    lf[(r4 + lane) * 4 + 1] = fminf(f1, 0.f) - log1pf(expf(-fabsf(f1)));
                    lf[(r4 + lane) * 4 + 2] = fminf(f2, 0.f) - log1pf(expf(-fabsf(f2)));
                    lf[(r4 + lane) * 4 + 3] = fminf(f3, 0.f) - log1pf(expf(-fabsf(f3)));
                }
            }
            __syncthreads();
            if (wave < 4) {
                const int hh = wave, bb = ck >> 7, cl = ck & 127;
                float v0 = *(const LAS float*)(lds + (lane >> 4) * 16384 + 12288 + ((lane & 15) * 4 + hh) * 4);
                float v1 = *(const LAS float*)(lds + (4 + (lane >> 4)) * 16384 + 12288 + ((lane & 15) * 4 + hh) * 4);
#pragma unroll
                for (int o = 1; o < 64; o <<= 1) { const float t0 = __shfl_up(v0, o), t1 = __shfl_up(v1, o); if (lane >= o) { v0 += t0; v1 += t1; } }
                const float tot0 = __shfl(v0, 63); v1 += tot0;
                float* dst = CUM + (size_t)(bb * 4 + hh) * SEQ + cl * 128;
                dst[lane] = v0; dst[64 + lane] = v1;
                if (lane == 63) LOGF[(bb * 4 + hh) * 128 + cl] = v1;
            }
            __syncthreads();
        }
      }
    }
#endif
    grid.sync();
    { PHASE_IDS (void)tid; (void)xcd_barrier_post(CTL + CW_BAR, (volatile LAS unsigned*)(lds + MISC_OFF)); }

#if PH_MASK & 2
    { PHASE_IDS
        for (int ck = blockIdx.x; ck < MTOK / 128; ck += G) {
            if (wave < 4) {
                const int hh = wave, bb = ck >> 7, cl = ck & 127; const float* tt = LOGF + (bb * 4 + hh) * 128;
                float a = (lane < cl ? tt[lane] : 0.f) + (64 + lane < cl ? tt[64 + lane] : 0.f);
                a = wave_sum(a);
                float* dst = CUM + (size_t)(bb * 4 + hh) * SEQ + cl * 128;
                dst[lane] += a; dst[64 + lane] += a;
            }
        }
        { pg8::Gemm g{XB, W0T, MTOK, 3072, 1024, 1024, 0}; pg8::StaticOrder S; S.init(MTOK, 3072, G, (int)blockIdx.x, WGM_P1);
          pg8::EpiProj E{PB, 2048, SS0, 2, 2, 2, 2, 1, even_qg, even_kg, 0.08838834764831845f * 1.4426950408889634f, (LAS float*)(lds + EPI_SCR_OFF), KT, 8, nullptr};
          pg8::gemm_phase<pg8::EpiProj, pg8::StaticOrder, true, true>(lds, g, S, E); }
        { pg8::Gemm g{W0VT, XB, 1024, MTOK, 1024, 1024, 0}; pg8::StaticOrder S; S.init(1024, MTOK, G, (int)blockIdx.x);
          pg8::EpiVt E{VT0, 1024, SS0, 0};
          pg8::gemm_phase<pg8::EpiVt, pg8::StaticOrder, true, true>(lds, g, S, E); }
#if REP1 > 1
        { pg8::Gemm g{XB, W0T, MTOK, 3072, 1024, 1024, 0}; pg8::StaticOrder S; S.init(MTOK, 3072, G, (int)blockIdx.x, WGM_P1);
          pg8::EpiProj E{PB, 2048, SS0, 2, 2, 2, 2, 1, even_qg, even_kg, 0.08838834764831845f * 1.4426950408889634f, (LAS float*)(lds + EPI_SCR_OFF), KT, 8, nullptr};
          pg8::gemm_phase<pg8::EpiProj, pg8::StaticOrder, true, true>(lds, g, S, E); }
        { pg8::Gemm g{W0VT, XB, 1024, MTOK, 1024, 1024, 0}; pg8::StaticOrder S; S.init(1024, MTOK, G, (int)blockIdx.x);
          pg8::EpiVt E{VT0, 1024, SS0, 0};
          pg8::gemm_phase<pg8::EpiVt, pg8::StaticOrder, true, true>(lds, g, S, E); }
#endif
    }
#endif
    XBAR();

#if PH_MASK & 4
    { PHASE_IDS
        float mq = fmaxf(fabsf(even_qg[lane]), fabsf(even_qg[lane + 64])), mk = fmaxf(fabsf(even_kg[lane]), fabsf(even_kg[lane + 64]));
        mq = wave_max(mq); mk = wave_max(mk);
        const float boundFox = 2.0f * 11.313708498984761f * mq * mk + 30.0f, boundSb = 30.0f;
        const unsigned myx = xb_xcc_id() & 7u;
        LAS unsigned* slotw = (LAS unsigned*)(lds + 2 * 33024 + 64);
        for (int rep = 0; rep < REP2; ++rep) {
        for (unsigned xo = 0; xo < 8u; ++xo) {
            const unsigned xq = (myx + xo) & 7u;
            for (;;) {
                if (tid == 0) *slotw = atomicAdd(CTL + 64 * (1 + xq + 16 * rep), 1u);
                __syncthreads();
                const unsigned idx = *slotw;
                __syncthreads();
                if (idx >= 64u) break;
                const int grp = idx >> 4, r = idx & 15, b = r >> 3, qb = (int)xq * 8 + 7 - (r & 7);
                att::l0_block<0>(b, 3 - grp, qb, PB, KT, VT0, CUM, MIX0, boundFox, lds, tid, wave, lane);
            }
        }
        for (unsigned xo = 0; xo < 8u; ++xo) {
            const unsigned xq = (myx + xo) & 7u;
            for (;;) {
                unsigned idx = 0;
                if (lane == 0) idx = atomicAdd(CTL + 64 * (9 + xq + 16 * rep), 1u);
                idx = __builtin_amdgcn_readfirstlane(idx);
                if (idx >= 512u) break;
                const int hh = idx >> 7, r = idx & 127, b = r >> 6, qt = (int)xq * 64 + 63 - (r & 63);
                att::l0_item<1>(b, hh, qt, PB, KT, VT0, CUM, MIX0, boundSb, lane);
            }
        }
        }
    }
#endif
    XBAR();

#if PH_MASK & 8
    { PHASE_IDS
        pg8::Gemm g{MIX0, W0O, MTOK, 1024, 1024, 1024, 0}; pg8::StaticOrder S; S.init(MTOK, 1024, G, (int)blockIdx.x);
#if REP3 > 1
        { pg8::EpiOut0 E0{x, VT0, SS0}; pg8::gemm_phase<pg8::EpiOut0, pg8::StaticOrder, true, true>(lds, g, S, E0); }
#endif
        pg8::EpiOut0 E{x, XB, SS1};
        pg8::gemm_phase<pg8::EpiOut0, pg8::StaticOrder, true, true>(lds, g, S, E);
    }
#endif
    XBAR();

#if PH_MASK & 16
    { PHASE_IDS
        { pg8::Gemm g{XB, W1T, MTOK, 3584, 1024, 1024, 0}; pg8::StaticOrder S; S.init(MTOK, 3584, G, (int)blockIdx.x, WGM_P4);
          pg8::EpiProj E{PB + (size_t)48 * 1024 * 1024 - 1536, 512, SS1, 6, 6, 0, 0, 0, odd_qg, odd_kg, 0.125f * 1.4426950408889634f, (LAS float*)(lds + EPI_SCR_OFF), KT, 24, PB};
          pg8::gemm_phase<pg8::EpiProj, pg8::StaticOrder, true, true>(lds, g, S, E); }
#pragma unroll 1
        for (int gi = 0; gi < 3; ++gi) {
            const int dsh = 2 * gi;
            pg8::Gemm g{W1VT + (size_t)gi * 512 * 1024, XB, 512, MTOK, 1024, 1024 << dsh, dsh}; pg8::StaticOrder S; S.init(512, MTOK, G, (int)blockIdx.x);
            pg8::EpiVt E{VT1 + (size_t)gi * 512 * MTOK, 512, SS1, dsh};
            pg8::gemm_phase<pg8::EpiVt, pg8::StaticOrder, true, true>(lds, g, S, E);
        }
#if REP4 > 1
        { pg8::Gemm g{XB, W1T, MTOK, 3584, 1024, 1024, 0}; pg8::StaticOrder S; S.init(MTOK, 3584, G, (int)blockIdx.x, WGM_P4);
          pg8::EpiProj E{PB + (size_t)48 * 1024 * 1024 - 1536, 512, SS1, 6, 6, 0, 0, 0, odd_qg, odd_kg, 0.125f * 1.4426950408889634f, (LAS float*)(lds + EPI_SCR_OFF), KT, 24, PB};
          pg8::gemm_phase<pg8::EpiProj, pg8::StaticOrder, true, true>(lds, g, S, E); }
#pragma unroll 1
        for (int gi = 0; gi < 3; ++gi) {
            const int dsh = 2 * gi;
            pg8::Gemm g{W1VT + (size_t)gi * 512 * 1024, XB, 512, MTOK, 1024, 1024 << dsh, dsh}; pg8::StaticOrder S; S.init(512, MTOK, G, (int)blockIdx.x);
            pg8::EpiVt E{VT1 + (size_t)gi * 512 * MTOK, 512, SS1, dsh};
            pg8::gemm_phase<pg8::EpiVt, pg8::StaticOrder, true, true>(lds, g, S, E);
        }
#endif
    }
#endif
    XBAR();

#if PH_MASK & 32
    { PHASE_IDS
        LAS bf16* og_run = (LAS bf16*)lds; LAS bf16* og_cur = (LAS bf16*)(lds + 65536);
        LAS float* lse_run = (LAS float*)(lds + 131072); LAS float* lse_cur = lse_run + 512; LAS float* lse_tmp = lse_run + 1024;
        LAS unsigned* slotw = (LAS unsigned*)(lds + 131072 + 6144);
        float skip2;
        { const float mq1 = wave_max(fabsf(odd_qg[lane])), mk1 = wave_max(fabsf(odd_kg[lane])); skip2 = (2.0f * 8.0f * mq1 * mk1 + 30.0f) * 1.4426950408889634f; }
        const unsigned myx = xb_xcc_id() & 7u;
        for (int rep = 0; rep < REP5; ++rep)
        for (unsigned xo = 0; xo < 8u; ++xo) {
          const unsigned xq = (myx + xo) & 7u;
          for (;;) {
            if (tid == 0) *slotw = atomicAdd(CTL + 64 * (40 + xq + 8 * rep), 1u);
            __syncthreads();
            const unsigned slot = *slotw;
            __syncthreads();
            if (slot >= 64u) break;
            const int bh = (int)xq * 2 + (int)(slot >> 5), tb = slot & 31, h = bh & 7, b = bh >> 3, T0 = tb * 512;
#pragma unroll 1
            for (int j = 0; j < 6; ++j) {
                if (j == 4) {
                    __syncthreads();
#pragma unroll 2
                    for (int k = 0; k < 8; ++k) {
                        const int idx = tid + 512 * k, tl = idx >> 3, ch = idx & 7;
                        const float l0 = lse_run[tl], l1 = lse_cur[tl], mx = fmaxf(l0, l1);
                        float w0 = att::ex2(l0 - mx), w1 = att::ex2(l1 - mx); const float sm = w0 + w1, inv = 1.0f / sm; w0 *= inv; w1 *= inv;
                        const pg8::u32x4 a0 = *(const LAS pg8::u32x4*)(og_run + (size_t)tl * 64 + 8 * ch), a1 = *(const LAS pg8::u32x4*)(og_cur + (size_t)tl * 64 + 8 * ch);
                        pg8::u32x4 res;
#pragma unroll
                        for (int e = 0; e < 4; ++e) res[e] = pg8::cvtpk(w0 * __uint_as_float(a0[e] << 16) + w1 * __uint_as_float(a1[e] << 16), w0 * __uint_as_float(a0[e] & 0xffff0000u) + w1 * __uint_as_float(a1[e] & 0xffff0000u));
                        *(LAS pg8::u32x4*)(og_run + (size_t)tl * 64 + 8 * ch) = res;
                        if (ch == 0) lse_tmp[tl] = mx + att::lg2(sm);
                    }
                    __syncthreads();
                }
                const int g = j >> 1, dsh = 2 * g, q16 = 2 * wave + (j & 1);
                const int r = (g == 0) ? 0 : (g == 1 ? (q16 >> 2) : q16);
                const int i0 = (g == 0) ? (T0 + 32 * q16) : (g == 1 ? ((T0 >> 2) + 32 * (q16 & 3)) : (T0 >> 4));
                const float slope2 = exp2f(-(float)(g * 8 + h + 1) * (1.0f / 3.0f)) * 1.4426950408889634f;
                att::dil_tile(g, dsh, b, h, r, i0, 32, T0, PB, KT, VT1, slope2, g == 0 ? og_run : og_cur, g == 0 ? lse_run : lse_cur, lane, skip2);
            }
            __syncthreads();
            pg8::u32x4 gtv[8];
#pragma unroll
            for (int k = 0; k < 8; ++k) { const int idx = tid + 512 * k; gtv[k] = *(const pg8::u32x4*)(PB + (size_t)48 * 1024 * 1024 + ((size_t)b * SEQ + T0 + (idx >> 3)) * 512 + h * 64 + 8 * (idx & 7)); }
#pragma unroll
            for (int k = 0; k < 8; ++k) {
                const int idx = tid + 512 * k, tl = idx >> 3, ch = idx & 7;
                const float l0 = lse_tmp[tl], l1 = lse_cur[tl], mx = fmaxf(l0, l1);
                float w0 = att::ex2(l0 - mx), w1 = att::ex2(l1 - mx); const float inv = 1.0f / (w0 + w1); w0 *= inv; w1 *= inv;
                const pg8::u32x4 a0 = *(const LAS pg8::u32x4*)(og_run + (size_t)tl * 64 + 8 * ch), a1 = *(const LAS pg8::u32x4*)(og_cur + (size_t)tl * 64 + 8 * ch);
                const size_t tok = (size_t)b * SEQ + T0 + tl;
                const pg8::u32x4 gt = gtv[k];
                pg8::u32x4 res;
#pragma unroll
                for (int e = 0; e < 4; ++e) {
                    const float lo = (w0 * __uint_as_float(a0[e] << 16) + w1 * __uint_as_float(a1[e] << 16)) * __uint_as_float(gt[e] << 16);
                    const float hi = (w0 * __uint_as_float(a0[e] & 0xffff0000u) + w1 * __uint_as_float(a1[e] & 0xffff0000u)) * __uint_as_float(gt[e] & 0xffff0000u);
                    res[e] = pg8::cvtpk(lo, hi);
                }
                *(pg8::u32x4*)(MIX1 + tok * 512 + h * 64 + 8 * ch) = res;
            }
            __syncthreads();
          }
        }
    }
#endif
    XBAR();

#ifdef EXTRA_SYNCS
    for (int es = 0; es < EXTRA_SYNCS; ++es) XBAR();
#endif
#if PH_MASK & 64
    { PHASE_IDS
        pg8::Gemm g{MIX1, W1O, MTOK, 1024, 512, 512, 0}; pg8::StaticOrder S; S.init(MTOK, 1024, G, (int)blockIdx.x);
#if REP6 > 1
        { pg8::EpiOut1 E0{XB, out}; pg8::gemm_phase<pg8::EpiOut1, pg8::StaticOrder, true, true>(lds, g, S, E0); }
#endif
        pg8::EpiOut1 E{XB, out};
        pg8::gemm_phase<pg8::EpiOut1, pg8::StaticOrder, true, true>(lds, g, S, E);
    }
#endif
}

extern "C" void kernel_launch(void* const* d_in, const int* in_sizes, int n_in, void* d_out, int out_size, void* d_ws, size_t ws_size, hipStream_t stream) {
    static int grid_blocks = 0;
    if (grid_blocks == 0) {
        if (n_in != 12 || ws_size < WS_END) { fprintf(stderr, "kernel_launch: unexpected inputs (n_in %d, ws %zu)\n", n_in, ws_size); grid_blocks = -1; return; }
        int dev = 0, cus = 0, per_cu = 0;
        (void)hipGetDevice(&dev);
        (void)hipDeviceGetAttribute(&cus, hipDeviceAttributeMultiprocessorCount, dev);
        if (hipFuncSetAttribute((const void*)mk_fwd, hipFuncAttributeMaxDynamicSharedMemorySize, LDS_BYTES) != hipSuccess) { fprintf(stderr, "kernel_launch: hipFuncSetAttribute failed\n"); grid_blocks = -1; return; }
        if (hipOccupancyMaxActiveBlocksPerMultiprocessor(&per_cu, (const void*)mk_fwd, 512, LDS_BYTES) != hipSuccess || per_cu < 1) { fprintf(stderr, "kernel_launch: occupancy query gives %d\n", per_cu); (void)hipGetLastError(); per_cu = 1; }
        grid_blocks = cus * 1;
        if (grid_blocks > cus * per_cu) grid_blocks = cus * per_cu;
    }
    if (grid_blocks < 0) return;
    Args a{};
    for (int i = 0; i < 12; ++i) a.in[i] = (const float*)d_in[i];
    a.out = (float*)d_out; a.ws = (unsigned char*)d_ws;
    void* kargs[] = {&a};
    hipError_t e = hipLaunchCooperativeKernel((const void*)mk_fwd, dim3(grid_blocks), dim3(512), kargs, LDS_BYTES, stream);
    if (e != hipSuccess) fprintf(stderr, "kernel_launch: cooperative launch failed: %s (grid %d)\n", hipGetErrorString(e), grid_blocks);
}
```

```cpp
#include <hip/hip_runtime.h>
#include <hip/hip_cooperative_groups.h>
#include <cstdio>
#include <cstdint>
namespace cg = cooperative_groups;
namespace pg8 {
#define PG8_LAS __attribute__((address_space(3)))
typedef unsigned short bf16_t;
typedef short bf16x8 __attribute__((ext_vector_type(8)));
typedef float f32x4 __attribute__((ext_vector_type(4)));
typedef unsigned u32x4 __attribute__((ext_vector_type(4)));
constexpr int BM = 256, BK = 64, HALF = 128, HTB = HALF * BK * 2  , STAGE_BYTES = 8 * HTB, NXCD = 8, WGM = 4;

__host__ __device__ __forceinline__ int lds_byte(int r, int c) { const int st = (r >> 4) * 2 + (c >> 5), rr = r & 15, cc = c & 31, ob = rr * 64 + cc * 2; return st * 1024 + (ob ^ (((ob >> 9) & 1) << 5)); }
__host__ __device__ __forceinline__ void stage_rc(int b, int& R, int& C) { const int st = b / 1024, sb = b % 1024, swz = sb ^ (((sb >> 9) & 1) << 5); R = (st >> 1) * 16 + swz / 64; C = (st & 1) * 32 + (swz % 64) / 2; }
__host__ __device__ __forceinline__ int perm32(int rho) { const int n = rho >> 4, i = rho & 15; return 8 * (i >> 2) + 4 * n + (i & 3); }

struct Unit { int pm, pn; };
struct Gemm { const bf16_t* A; const bf16_t* Bt; int M, N, K; int ldb; int dshift; };
__device__ __forceinline__ const char* b_tile(const Gemm& g, int pn) { const int p0 = pn * 256, bb = p0 >> 14, rem = p0 & 16383, ls = 14 - g.dshift, r = rem >> ls, i0 = rem & ((1 << ls) - 1);
    return (const char*)g.Bt + ((size_t)(bb * 16384 + r + (i0 << g.dshift)) * (size_t)g.K) * 2; }

struct StaticOrder {
    int nM, nN, nwg, G, c, wgm;
    __host__ __device__ void init(int M, int N, int G_, int c_, int wgm_ = WGM) { nM = M / BM; nN = N / BM; nwg = nM * nN; G = G_; c = c_; wgm = wgm_; }
    __host__ __device__ bool next(int i, Unit& u) const {
        const long L = (long)i * G + c; if (L >= nwg) return false;
        int wgid = (int)L; { const int q = nwg / NXCD, r = nwg % NXCD, xcd = wgid % NXCD, off = wgid / NXCD; wgid = (xcd < r ? xcd * (q + 1) : r * (q + 1) + (xcd - r) * q) + off; }
        const int nig = wgm * nN, gid = wgid / nig, fm = gid * wgm, gsz = (nM - fm) < wgm ? (nM - fm) : wgm;
        u.pm = fm + ((wgid % nig) % gsz); u.pn = (wgid % nig) / gsz; return true;
    }
    __device__ __forceinline__ void a_ready(const Unit&) const {}
    __device__ __forceinline__ void done(const Unit&) const {}
};
typedef unsigned u32x2 __attribute__((ext_vector_type(2)));
typedef float f32x2v __attribute__((ext_vector_type(2))); typedef __bf16 bf16x2v __attribute__((ext_vector_type(2)));
__device__ __forceinline__ unsigned cvtpk(float lo, float hi) { f32x2v v = {lo, hi}; bf16x2v b = __builtin_convertvector(v, bf16x2v); return __builtin_bit_cast(unsigned, b); }
__device__ __forceinline__ float silu_f(float v) { return v * __builtin_amdgcn_rcpf(1.0f + __builtin_amdgcn_exp2f(-1.4426950408889634f * v)); }
constexpr float RMS_EPS_F = 1e-6f;

struct EpiProj {
    static constexpr bool PERM = true, AFTER_DRAIN = false;
    bf16_t* O; int ldc; const float* ss; int n_qn, n_kn, n_qp, n_kp, hd128; const float* gq; const float* gk; float qscale; PG8_LAS float* scr; bf16_t* KT; int nkh; bf16_t* QT;
    __device__ __forceinline__ unsigned lane_off(bool tiled, int fr, int fq, int dsh) const {
        if (!tiled) return (unsigned)(fr * ldc + 8 * fq);
        const int NS = hd128 ? 8 : 4, r = fr & ((1 << dsh) - 1), il = fr >> dsh;
        return (unsigned)((((r << (9 - dsh)) * nkh * NS + (fq >> 1)) * 512) + (fq & 1) * 256 + il * 8);
    }
    __device__ __forceinline__ unsigned uni_off(bool tiled, int RU, int bj, int tix, int wc, int dsh) const {
        if (!tiled) return (unsigned)(RU * ldc + tix * BM + bj * HALF + wc * 32);
        const int NS = hd128 ? 8 : 4, head = hd128 ? tix * 2 + bj : tix * 4 + bj * 2 + (wc >> 1), sxu = hd128 ? wc * 2 : (wc & 1) * 2;
        const int bb = RU >> 14, q = (RU & 16383) >> dsh, Tu = bb * 512 + (q >> 5), pinu = q & 31;
        return (unsigned)((((Tu * nkh + head) * NS + sxu) * 512) + pinu * 8);
    }
    __device__ __forceinline__ void operator()(const f32x4 (&acc)[2][2][4][2], const Unit& u, int wr, int wc, int fr, int fq) const {
        const int pn = u.pn; int mode, tix; bool isk; const float* gain = gq; float sc = 1.f;
        bf16_t* T = KT;
        if (pn < n_qn) { mode = 2; gain = gq; sc = qscale; isk = (QT != nullptr); tix = pn; T = QT; }
        else if (pn < n_qn + n_kn) { mode = 2; gain = gk; isk = true; tix = pn - n_qn; }
        else if (pn < n_qn + n_kn + n_qp) { mode = 0; sc = qscale; isk = false; tix = pn - n_kn; }
        else if (pn < n_qn + n_kn + n_qp + n_kp) { mode = 0; isk = true; tix = pn - n_qn - n_qp; }
        else { mode = 1; isk = false; tix = pn - n_kn - n_kp; }
        const int rowl0 = wr * 64 + fr;
        const int dsh = hd128 ? 0 : 2 * (tix >> 1);
        bf16_t* const img = isk ? T : O; const unsigned loff = lane_off(isk, fr, fq, dsh);
        float rs[2][4];
#pragma unroll
        for (int ai = 0; ai < 2; ++ai)
#pragma unroll
            for (int m = 0; m < 4; ++m) rs[ai][m] = ss[u.pm * BM + ai * HALF + rowl0 + m * 16];
#pragma unroll
        for (int ai = 0; ai < 2; ++ai)
#pragma unroll
            for (int m = 0; m < 4; ++m) rs[ai][m] = __builtin_amdgcn_rsqf(rs[ai][m] * (1.0f / 1024.0f) + RMS_EPS_F);
        if (mode == 2) {
#pragma unroll
            for (int ai = 0; ai < 2; ++ai)
#pragma unroll
                for (int m = 0; m < 4; ++m)
#pragma unroll
                    for (int bj = 0; bj < 2; ++bj) {
                        const f32x4 a = acc[ai][bj][m][0], b = acc[ai][bj][m][1];
                        float p = (a[0] * a[0] + a[1] * a[1]) + (a[2] * a[2] + a[3] * a[3]) + (b[0] * b[0] + b[1] * b[1]) + (b[2] * b[2] + b[3] * b[3]);
                        p += __builtin_bit_cast(float, __builtin_amdgcn_ds_swizzle(__builtin_bit_cast(int, p), 0x401F));
                        { const auto rr = __builtin_amdgcn_permlane32_swap(__float_as_uint(p), __float_as_uint(p), false, false); p = __uint_as_float(rr[0]) + __uint_as_float(rr[1]); }
                        if (fq == 0) scr[((ai * HALF + rowl0 + m * 16) * 2 + bj) * 4 + wc] = p;
                    }
            asm volatile("s_waitcnt lgkmcnt(0)" ::: "memory"); __builtin_amdgcn_s_barrier(); asm volatile("" ::: "memory");
            const int cih = (hd128 ? wc * 32 : (wc & 1) * 32) + 8 * fq;
            const f32x4 g0 = *(const f32x4*)(gain + cih), g1 = *(const f32x4*)(gain + cih + 4);
            const float inv_hd = hd128 ? (1.0f / 128.0f) : (1.0f / 64.0f);
#pragma unroll
            for (int ai = 0; ai < 2; ++ai)
#pragma unroll
                for (int m = 0; m < 4; ++m) {
                    const int rowl = ai * HALF + rowl0 + m * 16; const int row = u.pm * BM + rowl;
                    const float r = rs[ai][m];
#pragma unroll
                    for (int bj = 0; bj < 2; ++bj) {
                        const f32x4 pp = *(const PG8_LAS f32x4*)(scr + (rowl * 2 + bj) * 4);
                        const float tot = hd128 ? ((pp[0] + pp[1]) + (pp[2] + pp[3])) : ((wc < 2) ? (pp[0] + pp[1]) : (pp[2] + pp[3]));
                        const float f = r * __builtin_amdgcn_rsqf(tot * r * r * inv_hd + RMS_EPS_F) * sc;
                        const f32x4 a = acc[ai][bj][m][0] * g0 * f, b = acc[ai][bj][m][1] * g1 * f;
                        u32x4 w; w.x = cvtpk(a[0], a[1]); w.y = cvtpk(a[2], a[3]); w.z = cvtpk(b[0], b[1]); w.w = cvtpk(b[2], b[3]);
                        *(u32x4*)(img + (uni_off(isk, u.pm * BM + ai * HALF + wr * 64 + m * 16, bj, tix, wc, dsh) + loff)) = w;
                    }
                    asm volatile("" ::: "memory");
                }
        } else {
#pragma unroll
            for (int ai = 0; ai < 2; ++ai)
#pragma unroll
                for (int m = 0; m < 4; ++m) {
                    const int row = u.pm * BM + ai * HALF + rowl0 + m * 16;
                    const float r = rs[ai][m] * sc;
#pragma unroll
                    for (int bj = 0; bj < 2; ++bj) {
                        f32x4 a = acc[ai][bj][m][0] * r, b = acc[ai][bj][m][1] * r;
                        if (mode == 1) { a = (f32x4){silu_f(a[0]), silu_f(a[1]), silu_f(a[2]), silu_f(a[3])}; b = (f32x4){silu_f(b[0]), silu_f(b[1]), silu_f(b[2]), silu_f(b[3])}; }
                        u32x4 w; w.x = cvtpk(a[0], a[1]); w.y = cvtpk(a[2], a[3]); w.z = cvtpk(b[0], b[1]); w.w = cvtpk(b[2], b[3]);
                        *(u32x4*)(img + (uni_off(isk, u.pm * BM + ai * HALF + wr * 64 + m * 16, bj, tix, wc, dsh) + loff)) = w;
                    }
                    asm volatile("" ::: "memory");
                }
        }
    }
};
struct EpiVt {
    static constexpr bool PERM = true, AFTER_DRAIN = false;
    bf16_t* O; int F; const float* ss; int dshift;
    __device__ __forceinline__ void operator()(const f32x4 (&acc)[2][2][4][2], const Unit& u, int wr, int wc, int fr, int fq) const {
        float cs[2][8]; const int ls = 14 - dshift;
#pragma unroll
        for (int bj = 0; bj < 2; ++bj) { const int p0 = u.pn * BM + bj * HALF + wc * 32 + 8 * fq, bb = p0 >> 14, rem = p0 & 16383, r = rem >> ls, i0 = rem & ((1 << ls) - 1), tok0 = bb * 16384 + r + (i0 << dshift);
#pragma unroll
            for (int j = 0; j < 8; ++j) cs[bj][j] = __builtin_amdgcn_rsqf(ss[tok0 + (j << dshift)] * (1.0f / 1024.0f) + RMS_EPS_F); }
        const int s2 = fq >> 1, a2 = fq & 1;
#pragma unroll
        for (int ai = 0; ai < 2; ++ai)
#pragma unroll
            for (int m = 0; m < 4; ++m) {
                const int row = u.pm * BM + ai * HALF + wr * 64 + m * 16 + fr;
#pragma unroll
                for (int bj = 0; bj < 2; ++bj) {
                    const f32x4 a = acc[ai][bj][m][0], b = acc[ai][bj][m][1];
                    const int pblk = (u.pn * BM + bj * HALF + wc * 32) >> 5;
                    bf16_t* dst = O + (size_t)pblk * F * 32 + ((((row >> 5) * 2 + s2) * 2) * 32 + (row & 31)) * 8 + 4 * a2;
                    u32x2 w0, w1; w0.x = cvtpk(a[0] * cs[bj][0], a[1] * cs[bj][1]); w0.y = cvtpk(a[2] * cs[bj][2], a[3] * cs[bj][3]); w1.x = cvtpk(b[0] * cs[bj][4], b[1] * cs[bj][5]); w1.y = cvtpk(b[2] * cs[bj][6], b[3] * cs[bj][7]);
                    *(u32x2*)dst = w0; *(u32x2*)(dst + 256) = w1;
                }
            }
    }
};
struct EpiOut0 {
    static constexpr bool PERM = true, AFTER_DRAIN = false;
    const float* res; bf16_t* hb; float* ssn;
    __device__ __forceinline__ void operator()(const f32x4 (&acc)[2][2][4][2], const Unit& u, int wr, int wc, int fr, int fq) const {
#pragma unroll
        for (int ai = 0; ai < 2; ++ai)
#pragma unroll
            for (int m = 0; m < 4; ++m) {
                const int row = u.pm * BM + ai * HALF + wr * 64 + m * 16 + fr; float part = 0.f;
#pragma unroll
                for (int bj = 0; bj < 2; ++bj) {
                    const unsigned off = (unsigned)(row * 1024 + u.pn * BM + bj * HALF + wc * 32 + 8 * fq);
                    const f32x4 a = acc[ai][bj][m][0] + *(const f32x4*)(res + off), b = acc[ai][bj][m][1] + *(const f32x4*)(res + off + 4);
                    part += (a[0] * a[0] + a[1] * a[1]) + (a[2] * a[2] + a[3] * a[3]) + (b[0] * b[0] + b[1] * b[1]) + (b[2] * b[2] + b[3] * b[3]);
                    u32x4 w; w.x = cvtpk(a[0], a[1]); w.y = cvtpk(a[2], a[3]); w.z = cvtpk(b[0], b[1]); w.w = cvtpk(b[2], b[3]);
                    *(u32x4*)(hb + off) = w;
                }
                part += __shfl_xor(part, 16); part += __shfl_xor(part, 32); if (fq == 0) atomicAdd(ssn + row, part);
                asm volatile("" ::: "memory");
            }
    }
};
struct EpiOut1 {
    static constexpr bool PERM = true, AFTER_DRAIN = false;
    const bf16_t* hb; float* out;
    __device__ __forceinline__ void operator()(const f32x4 (&acc)[2][2][4][2], const Unit& u, int wr, int wc, int fr, int fq) const {
#pragma unroll
        for (int ai = 0; ai < 2; ++ai)
#pragma unroll
            for (int m = 0; m < 4; ++m) {
                const int row = u.pm * BM + ai * HALF + wr * 64 + m * 16 + fr;
#pragma unroll
                for (int bj = 0; bj < 2; ++bj) {
                    const unsigned off = (unsigned)(row * 1024 + u.pn * BM + bj * HALF + wc * 32 + 8 * fq);
                    const u32x4 h = *(const u32x4*)(hb + off);
                    f32x4 a = acc[ai][bj][m][0], b = acc[ai][bj][m][1];
                    a[0] += __uint_as_float(h.x << 16); a[1] += __uint_as_float(h.x & 0xffff0000u); a[2] += __uint_as_float(h.y << 16); a[3] += __uint_as_float(h.y & 0xffff0000u);
                    b[0] += __uint_as_float(h.z << 16); b[1] += __uint_as_float(h.z & 0xffff0000u); b[2] += __uint_as_float(h.w << 16); b[3] += __uint_as_float(h.w & 0xffff0000u);
                    *(f32x4*)(out + off) = a; *(f32x4*)(out + off + 4) = b;
                }
                asm volatile("" ::: "memory");
            }
    }
};
template <class Epi, class Sched, bool ALIGN_EPI = false, bool SP2 = false>
__device__ __forceinline__ void gemm_phase(PG8_LAS unsigned char* lds, const Gemm g, const Sched& S, const Epi& E) {
    int tid_ = threadIdx.x; asm volatile("" : "+v"(tid_));
    const int tid = tid_, wid = __builtin_amdgcn_readfirstlane(tid >> 6), lane = tid & 63, wr = wid >> 2, wc = wid & 3, fr = lane & 15, fq = lane >> 4;
    const int K = g.K, nt = K / BK;
    unsigned voffA[2], voffB[2];
#pragma unroll
    for (int i = 0; i < 2; ++i) { int R, C; stage_rc(tid * 16 + i * 8192, R, C); const int Rb = Epi::PERM ? ((R & ~31) + perm32(R & 31)) : R;
        voffA[i] = (unsigned)(R * K + C) * 2u; voffB[i] = (unsigned)(Rb * g.ldb + C) * 2u; }
    const size_t kstep = (size_t)(BK * 2);
    const size_t hstep = (size_t)HALF * K * 2;
    const size_t tstep = 2 * hstep; const size_t hstepB = (size_t)HALF * g.ldb * 2;
    const unsigned ldsw = (unsigned)wid * 1024u;
    const int aoff = lds_byte(wr * 64 + fr, fq * 8), boff = lds_byte(wc * 32 + fr, fq * 8);
#define PG8_SA(b, h) (((b) * 2 + (h)) * HTB)
#define PG8_SB(b, h) ((4 + (b) * 2 + (h)) * HTB)
#define PG8_STAGE(bufoff, gbase, voff) do { _Pragma("unroll") for (int _i = 0; _i < 2; ++_i) \
        __builtin_amdgcn_global_load_lds((const unsigned*)((const char*)(gbase) + (voff)[_i]), (PG8_LAS unsigned*)(lds + (bufoff) + ldsw + _i * 8192), 16, 0, 0); } while (0)
#define PG8_LDA(dst, b, h) do { _Pragma("unroll") for (int m = 0; m < 4; ++m) _Pragma("unroll") for (int k = 0; k < 2; ++k) dst[m][k] = *(const PG8_LAS bf16x8*)(lds + PG8_SA(b, h) + aoff + m * 2048 + k * 1024); } while (0)
#define PG8_LDB(dst, b, h) do { _Pragma("unroll") for (int n = 0; n < 2; ++n) _Pragma("unroll") for (int k = 0; k < 2; ++k) dst[n][k] = *(const PG8_LAS bf16x8*)(lds + PG8_SB(b, h) + boff + n * 2048 + k * 1024); } while (0)
#define PG8_MMA(ai, bj, At, Bt) do { __builtin_amdgcn_s_setprio(1); _Pragma("unroll") for (int m = 0; m < 4; ++m) _Pragma("unroll") for (int n = 0; n < 2; ++n) _Pragma("unroll") for (int k = 0; k < 2; ++k) \
        acc[ai][bj][m][n] = __builtin_amdgcn_mfma_f32_16x16x32_bf16(Bt[n][k], At[m][k], acc[ai][bj][m][n], 0, 0, 0); __builtin_amdgcn_s_setprio(0); } while (0)
#define PG8_WAIT_V(n) asm volatile("s_waitcnt vmcnt(" #n ")" ::: "memory")
#define PG8_WAIT_L(n) asm volatile("s_waitcnt lgkmcnt(" #n ")" ::: "memory")
#define PG8_BAR __builtin_amdgcn_s_barrier()
#define PG8_SCHED __builtin_amdgcn_sched_barrier(0)
    Unit cur, nxt; int ui = 0;
    if (!S.next(0, cur)) return;
    f32x4 acc[2][2][4][2];
#pragma unroll
    for (int a = 0; a < 2; ++a)
#pragma unroll
        for (int b = 0; b < 2; ++b)
#pragma unroll
            for (int m = 0; m < 4; ++m)
#pragma unroll
                for (int n = 0; n < 2; ++n) acc[a][b][m][n] = (f32x4){0.f, 0.f, 0.f, 0.f};
    bf16x8 At[4][2], B0[2][2], B1[2][2];
    const char* cA = (const char*)g.A + (size_t)cur.pm * tstep; const char* cB = b_tile(g, cur.pn);
    S.a_ready(cur);
    if constexpr (SP2) {
        PG8_STAGE(PG8_SB(0, 0), cB, voffB); PG8_STAGE(PG8_SB(0, 1), cB + hstepB, voffB); PG8_STAGE(PG8_SA(0, 0), cA, voffA); PG8_STAGE(PG8_SA(0, 1), cA + hstep, voffA);
        if (wr == 1) PG8_BAR;
        PG8_WAIT_V(2); PG8_BAR;
        PG8_STAGE(PG8_SB(1, 0), cB + kstep, voffB); PG8_STAGE(PG8_SA(1, 0), cA + kstep, voffA); PG8_STAGE(PG8_SB(1, 1), cB + hstepB + kstep, voffB);
        PG8_WAIT_V(6); PG8_BAR;
    } else {
        PG8_STAGE(PG8_SB(0, 0), cB, voffB); PG8_STAGE(PG8_SA(0, 0), cA, voffA); PG8_STAGE(PG8_SB(0, 1), cB + hstepB, voffB); PG8_STAGE(PG8_SA(0, 1), cA + hstep, voffA);
        if (wr == 1) PG8_BAR;
        PG8_WAIT_V(4); PG8_BAR;
        PG8_STAGE(PG8_SB(1, 0), cB + kstep, voffB); PG8_STAGE(PG8_SA(1, 0), cA + kstep, voffA); PG8_STAGE(PG8_SB(1, 1), cB + hstepB + kstep, voffB);
        PG8_WAIT_V(6); PG8_BAR;
    }
    for (;;) {
        const bool has_next = S.next(ui + 1, nxt);
        const char* nA = has_next ? (const char*)g.A + (size_t)nxt.pm * tstep : cA; const char* nB = has_next ? b_tile(g, nxt.pn) : cB;
        for (int t = 0; t < nt; t += 2) {
            const bool last = (t == nt - 2);
            const char* a1 = cA + (size_t)(t + 1) * kstep;
            const char* a2 = last ? nA : cA + (size_t)(t + 2) * kstep; const char* b2 = last ? nB : cB + (size_t)(t + 2) * kstep;
            const char* a3 = a2 + kstep; const char* b3 = b2 + kstep;
            if (last && has_next) S.a_ready(nxt);
            if constexpr (SP2) {
            PG8_LDB(B0, 0, 0); PG8_LDB(B1, 0, 1); PG8_SCHED; PG8_LDA(At, 0, 0); PG8_STAGE(PG8_SA(1, 1), a1 + hstep, voffA);
            PG8_WAIT_V(8); PG8_WAIT_L(0); PG8_BAR; PG8_MMA(0, 0, At, B0); PG8_MMA(0, 1, At, B1); PG8_BAR; PG8_SCHED;
            PG8_LDA(At, 0, 1); PG8_STAGE(PG8_SB(0, 0), b2, voffB); PG8_STAGE(PG8_SB(0, 1), b2 + hstepB, voffB); PG8_STAGE(PG8_SA(0, 0), a2, voffA);
            PG8_WAIT_V(8); PG8_WAIT_L(0); PG8_BAR; PG8_MMA(1, 0, At, B0); PG8_MMA(1, 1, At, B1); PG8_BAR; PG8_SCHED;
            PG8_LDB(B0, 1, 0); PG8_LDB(B1, 1, 1); PG8_SCHED; PG8_LDA(At, 1, 0); PG8_STAGE(PG8_SA(0, 1), a2 + hstep, voffA);
            PG8_WAIT_V(8); PG8_WAIT_L(0); PG8_BAR; PG8_MMA(0, 0, At, B0); PG8_MMA(0, 1, At, B1); PG8_BAR; PG8_SCHED;
            PG8_LDA(At, 1, 1); PG8_STAGE(PG8_SB(1, 0), b3, voffB); PG8_STAGE(PG8_SB(1, 1), b3 + hstepB, voffB); PG8_STAGE(PG8_SA(1, 0), a3, voffA);
            PG8_WAIT_V(8); PG8_WAIT_L(0); PG8_BAR; PG8_MMA(1, 0, At, B0); PG8_MMA(1, 1, At, B1); PG8_BAR; PG8_SCHED;
            } else {
            PG8_LDB(B0, 0, 0); PG8_SCHED; PG8_LDA(At, 0, 0); PG8_STAGE(PG8_SA(1, 1), a1 + hstep, voffA);
            PG8_WAIT_L(8); PG8_BAR; PG8_WAIT_L(0); PG8_MMA(0, 0, At, B0); PG8_BAR; PG8_SCHED;
            PG8_LDB(B1, 0, 1); PG8_STAGE(PG8_SB(0, 0), b2, voffB);
            PG8_BAR; PG8_WAIT_L(0); PG8_MMA(0, 1, At, B1); PG8_BAR;
            PG8_LDA(At, 0, 1); PG8_STAGE(PG8_SA(0, 0), a2, voffA);
            PG8_BAR; PG8_WAIT_L(0); PG8_MMA(1, 0, At, B0); PG8_BAR; PG8_SCHED;
            PG8_STAGE(PG8_SB(0, 1), b2 + hstepB, voffB);
            PG8_WAIT_V(6); PG8_BAR; PG8_MMA(1, 1, At, B1); PG8_BAR;
            PG8_LDB(B0, 1, 0); PG8_SCHED; PG8_LDA(At, 1, 0); PG8_STAGE(PG8_SA(0, 1), a2 + hstep, voffA);
            PG8_WAIT_L(8); PG8_BAR; PG8_WAIT_L(0); PG8_MMA(0, 0, At, B0); PG8_BAR; PG8_SCHED;
            PG8_LDB(B1, 1, 1); PG8_STAGE(PG8_SB(1, 0), b3, voffB);
            PG8_BAR; PG8_WAIT_L(0); PG8_MMA(0, 1, At, B1); PG8_BAR;
            PG8_LDA(At, 1, 1); PG8_STAGE(PG8_SA(1, 0), a3, voffA);
            PG8_BAR; PG8_WAIT_L(0); PG8_MMA(1, 0, At, B0); PG8_BAR; PG8_SCHED;
            PG8_STAGE(PG8_SB(1, 1), b3 + hstepB, voffB);
            PG8_WAIT_V(6); PG8_BAR; PG8_MMA(1, 1, At, B1); PG8_BAR;
            }
        }
        if constexpr (ALIGN_EPI) { if (wr == 0) PG8_BAR; }
        if constexpr (!Epi::AFTER_DRAIN) { E(acc, cur, wr, wc, fr, fq); S.done(cur); }
        if (!has_next) break;
#pragma unroll
        for (int a = 0; a < 2; ++a)
#pragma unroll
            for (int b = 0; b < 2; ++b)
#pragma unroll
                for (int m = 0; m < 4; ++m)
#pragma unroll
                    for (int n = 0; n < 2; ++n) acc[a][b][m][n] = (f32x4){0.f, 0.f, 0.f, 0.f};
        cur = nxt; cA = nA; cB = nB; ++ui;
        if constexpr (ALIGN_EPI) { if (wr == 1) PG8_BAR; }
    }
    PG8_WAIT_V(0);
    if constexpr (!ALIGN_EPI) { if (wr == 0) PG8_BAR; }
    PG8_BAR;
    if constexpr (Epi::AFTER_DRAIN) { E.fused(acc, cur, wr, wc, fr, fq, lds, wid, lane); S.done(cur); }
#undef PG8_SA
#undef PG8_SB
#undef PG8_STAGE
#undef PG8_LDA
#undef PG8_LDB
#undef PG8_MMA
#undef PG8_WAIT_V
#undef PG8_WAIT_L
#undef PG8_BAR
#undef PG8_SCHED
}
}
namespace att {
typedef unsigned short bf16_t;
typedef short bf16x8 __attribute__((ext_vector_type(8)));
typedef short s16x4 __attribute__((ext_vector_type(4)));
typedef float f32x4 __attribute__((ext_vector_type(4)));
typedef float f32x16 __attribute__((ext_vector_type(16)));
typedef unsigned u32x4 __attribute__((ext_vector_type(4)));
typedef unsigned u32x2 __attribute__((ext_vector_type(2)));
using pg8::cvtpk;
constexpr int S = 16384;
constexpr float LOG2E = 1.4426950408889634f;
constexpr float NEG = -1.0e30f;
__device__ __forceinline__ float ex2(float x) { return __builtin_amdgcn_exp2f(x); }
__device__ __forceinline__ float lg2(float x) { return __builtin_amdgcn_logf(x); }
__device__ __forceinline__ float half_max(float v) { const auto rr = __builtin_amdgcn_permlane32_swap(__float_as_uint(v), __float_as_uint(v), false, false); return fmaxf(__uint_as_float(rr[0]), __uint_as_float(rr[1])); }
__device__ __forceinline__ float half_sum(float v) { const auto rr = __builtin_amdgcn_permlane32_swap(__float_as_uint(v), __float_as_uint(v), false, false); return __uint_as_float(rr[0]) + __uint_as_float(rr[1]); }
__device__ __forceinline__ float other_half(float v, int half) { const auto rr = __builtin_amdgcn_permlane32_swap(__float_as_uint(v), __float_as_uint(v), false, false); return half == 0 ? __uint_as_float(rr[1]) : __uint_as_float(rr[0]); }
__device__ __forceinline__ bf16x8 pack8(const f32x16& p, int s2) {
    u32x4 w; w.x = cvtpk(p[8 * s2 + 0], p[8 * s2 + 1]); w.y = cvtpk(p[8 * s2 + 2], p[8 * s2 + 3]); w.z = cvtpk(p[8 * s2 + 4], p[8 * s2 + 5]); w.w = cvtpk(p[8 * s2 + 6], p[8 * s2 + 7]);
    return __builtin_bit_cast(bf16x8, w);
}
__device__ __forceinline__ bf16x8 cat44(s16x4 lo, s16x4 hi) { return (bf16x8){lo[0], lo[1], lo[2], lo[3], hi[0], hi[1], hi[2], hi[3]}; }
#define ATT_ZERO16 (f32x16){0.f,0.f,0.f,0.f,0.f,0.f,0.f,0.f,0.f,0.f,0.f,0.f,0.f,0.f,0.f,0.f}

template <int MODE>
__device__ __forceinline__ void l0_item(int b, int h, int qt, const bf16_t* __restrict__ P0, const bf16_t* __restrict__ KT0, const bf16_t* __restrict__ Vt0, const float* __restrict__ cum, bf16_t* __restrict__ MIX0, float boundN, int lane) {
    const int q = lane & 31, half = lane >> 5, t0 = qt * 32;
    const size_t tokb = (size_t)b * S;
    const int qcol = (MODE == 0 ? 0 : 512) + h * 128, khead = (MODE == 0 ? 0 : 4) + h, vrow = (MODE == 0 ? 0 : 512) + h * 128, ocol = (MODE == 0 ? 0 : 512) + h * 128;
    bf16x8 qf[8];
    { const bf16_t* qp = P0 + (tokb + t0 + q) * 2048 + qcol + 8 * half;
#pragma unroll
      for (int s = 0; s < 8; ++s) qf[s] = *(const bf16x8*)(qp + 16 * s); }
    const float* cb = cum + (size_t)(b * 4 + h) * S;
    float cref = 0.f; int ktmin = 0;
    if (MODE == 0) {
        cref = cb[t0];
        int cnt = 0;
        for (int base = qt - 1; base >= 0; base -= 64) {
            const int kt = base - lane;
            const bool ok = (kt >= 0) && ((cref - cb[(kt < 0 ? 0 : kt) * 32 + 31]) >= -boundN);
            const unsigned long long bal = __ballot(ok);
            const int n = (bal == ~0ull) ? 64 : (__ffsll((unsigned long long)~bal) - 1);
            cnt += n; if (n < 64) break;
        }
        ktmin = qt - cnt;
    }
    f32x16 o[4] = {ATT_ZERO16, ATT_ZERO16, ATT_ZERO16, ATT_ZERO16};
    float mrun = NEG, lrun = 0.f;
    const float thr2 = -boundN * LOG2E;
    bf16x8 kn[8];
    const bf16_t* kbase = KT0 + (size_t)khead * 4096 + half * 256 + q * 8;
    { const bf16_t* kp = kbase + (size_t)((tokb + qt * 32) >> 5) * 32768;
#pragma unroll
      for (int s = 0; s < 8; ++s) kn[s] = *(const bf16x8*)(kp + 512 * s); }
    for (int kt = qt; kt >= ktmin; --kt) {
        const int s0 = kt * 32;
        bf16x8 kf[8];
#pragma unroll
        for (int s = 0; s < 8; ++s) kf[s] = kn[s];
        { const int sn = (kt > 0 ? kt - 1 : 0) * 32;
          const bf16_t* kp = kbase + (size_t)((tokb + sn) >> 5) * 32768;
#pragma unroll
          for (int s = 0; s < 8; ++s) kn[s] = *(const bf16x8*)(kp + 512 * s); }
        f32x4 cv[4];
        if (MODE == 0) {
#pragma unroll
            for (int a = 0; a < 4; ++a) cv[a] = *(const f32x4*)(cb + s0 + 8 * a + 4 * half);
        }
        f32x16 sa = ATT_ZERO16;
        __builtin_amdgcn_s_setprio(1);
#pragma unroll
        for (int s = 0; s < 8; ++s) sa = __builtin_amdgcn_mfma_f32_32x32x16_bf16(kf[s], qf[s], sa, 0, 0, 0);
        __builtin_amdgcn_s_setprio(0);
        bf16x8 vf[4][2];
        { const bf16_t* vp = Vt0 + (size_t)((tokb + s0) >> 5) * 32768 + (vrow >> 5) * 1024 + half * 256 + q * 8;
#pragma unroll
          for (int dt = 0; dt < 4; ++dt)
#pragma unroll
              for (int s2 = 0; s2 < 2; ++s2) vf[dt][s2] = *(const bf16x8*)(vp + dt * 1024 + s2 * 512); }
        f32x16 p;
        if (MODE == 0) {
#pragma unroll
            for (int a = 0; a < 4; ++a)
#pragma unroll
                for (int e = 0; e < 4; ++e) sa[4 * a + e] += (cref - cv[a][e]) * LOG2E;
            if (kt == qt) {
#pragma unroll
                for (int i = 0; i < 16; ++i) { const int key = (i & 3) + 8 * (i >> 2) + 4 * half; if (key > q) sa[i] = NEG; }
            }
            float tm = sa[0];
#pragma unroll
            for (int i = 1; i < 16; ++i) tm = fmaxf(tm, sa[i]);
            tm = half_max(tm);
            const float mn = fmaxf(mrun, tm), alpha = ex2(mrun - mn); mrun = mn;
            float ps = 0.f;
#pragma unroll
            for (int i = 0; i < 16; ++i) { p[i] = ex2(sa[i] - mn); ps += p[i]; }
            ps = half_sum(ps); lrun = lrun * alpha + ps;
#pragma unroll
            for (int dt = 0; dt < 4; ++dt) o[dt] = o[dt] * alpha;
        } else {
            f32x16 l1;
#pragma unroll
            for (int i = 0; i < 16; ++i) { const float z = sa[i], u = lg2(1.0f + ex2(-fabsf(z))), sp = fmaxf(z, 0.f) + u; l1[i] = -sp; p[i] = z - sp; }
            const bool diag = (kt == qt);
            if (diag) {
#pragma unroll
                for (int i = 0; i < 16; ++i) { const int key = (i & 3) + 8 * (i >> 2) + 4 * half; if (key >= q) l1[i] = 0.f; }
            }
            float R[4], ex[16];
#pragma unroll
            for (int a = 0; a < 4; ++a) { ex[4 * a + 3] = 0.f; ex[4 * a + 2] = l1[4 * a + 3]; ex[4 * a + 1] = l1[4 * a + 2] + ex[4 * a + 2]; ex[4 * a + 0] = l1[4 * a + 1] + ex[4 * a + 1]; R[a] = l1[4 * a] + ex[4 * a]; }
            float Ro[4], T[4];
#pragma unroll
            for (int a = 0; a < 4; ++a) { Ro[a] = other_half(R[a], half); T[a] = R[a] + Ro[a]; }
            float suf[4]; suf[3] = 0.f; suf[2] = T[3]; suf[1] = T[2] + suf[2]; suf[0] = T[1] + suf[1];
#pragma unroll
            for (int a = 0; a < 4; ++a) { const float off = lrun + suf[a] + (half == 0 ? Ro[a] : 0.f);
#pragma unroll
                for (int e = 0; e < 4; ++e) p[4 * a + e] = ex2(p[4 * a + e] + off + ex[4 * a + e]); }
            if (diag) {
#pragma unroll
                for (int i = 0; i < 16; ++i) { const int key = (i & 3) + 8 * (i >> 2) + 4 * half; if (key >= q) p[i] = 0.f; }
            }
            lrun += T[0] + suf[0];
        }
        const bf16x8 pb0 = pack8(p, 0), pb1 = pack8(p, 1);
        __builtin_amdgcn_s_setprio(1);
#pragma unroll
        for (int dt = 0; dt < 4; ++dt) { o[dt] = __builtin_amdgcn_mfma_f32_32x32x16_bf16(vf[dt][0], pb0, o[dt], 0, 0, 0); o[dt] = __builtin_amdgcn_mfma_f32_32x32x16_bf16(vf[dt][1], pb1, o[dt], 0, 0, 0); }
        __builtin_amdgcn_s_setprio(0);
        if (MODE == 1) { if (__all(lrun < thr2)) break; }
    }
    const float inv = (MODE == 0) ? __builtin_amdgcn_rcpf(lrun) : 1.0f;
    const bf16_t* gp = P0 + (tokb + t0 + q) * 2048 + 1024 + ocol + 4 * half;
    bf16_t* op = MIX0 + (tokb + t0 + q) * 1024 + ocol + 4 * half;
#pragma unroll
    for (int dt = 0; dt < 4; ++dt)
#pragma unroll
        for (int a = 0; a < 4; ++a) {
            const u32x2 gw = *(const u32x2*)(gp + dt * 32 + 8 * a);
            const float g0 = __uint_as_float(gw.x << 16), g1 = __uint_as_float(gw.x & 0xffff0000u), g2 = __uint_as_float(gw.y << 16), g3 = __uint_as_float(gw.y & 0xffff0000u);
            u32x2 w; w.x = cvtpk(o[dt][4 * a + 0] * inv * g0, o[dt][4 * a + 1] * inv * g1); w.y = cvtpk(o[dt][4 * a + 2] * inv * g2, o[dt][4 * a + 3] * inv * g3);
            *(u32x2*)(op + dt * 32 + 8 * a) = w;
        }
}

template <int MODE>
__device__ __forceinline__ void l0_block(int b, int h, int qb, const bf16_t* __restrict__ P0, const bf16_t* __restrict__ KT0, const bf16_t* __restrict__ Vt0, const float* __restrict__ cum, bf16_t* __restrict__ MIX0, float boundN, PG8_LAS unsigned char* lds, int tid, int wave, int lane) {
    const int qt = qb * 8 + wave;
    const int q = lane & 31, half = lane >> 5, t0 = qt * 32;
    const size_t tokb = (size_t)b * S;
    const int qcol = (MODE == 0 ? 0 : 512) + h * 128, khead = (MODE == 0 ? 0 : 4) + h, vrow = (MODE == 0 ? 0 : 512) + h * 128, ocol = (MODE == 0 ? 0 : 512) + h * 128;
    bf16x8 qf[8];
    { const bf16_t* qp = P0 + (tokb + t0 + q) * 2048 + qcol + 8 * half;
#pragma unroll
      for (int s = 0; s < 8; ++s) qf[s] = *(const bf16x8*)(qp + 16 * s); }
    const float* cb = cum + (size_t)(b * 4 + h) * S;
    float cref = 0.f; int ktmin = 0;
    if (MODE == 0) {
        cref = cb[t0];
        int cnt = 0;
        for (int base = qt - 1; base >= 0; base -= 64) {
            const int kt = base - lane;
            const bool ok = (kt >= 0) && ((cref - cb[(kt < 0 ? 0 : kt) * 32 + 31]) >= -boundN);
            const unsigned long long bal = __ballot(ok);
            const int n = (bal == ~0ull) ? 64 : (__ffsll((unsigned long long)~bal) - 1);
            cnt += n; if (n < 64) break;
        }
        ktmin = qt - cnt;
    }
    f32x16 o[4] = {ATT_ZERO16, ATT_ZERO16, ATT_ZERO16, ATT_ZERO16};
    float mrun = NEG, lrun = 0.f;
    const float thr2 = -boundN * LOG2E;
    constexpr int PBUF = 32768 + 256;
    PG8_LAS int* sh = (PG8_LAS int*)(lds + 2 * PBUF);
    if (lane == 0) sh[wave] = ktmin;
    __syncthreads();
    const int kt_hi = qb * 8 + 7, kt_lo = (MODE == 0) ? sh[0] : 0;
    const int kk_hi = kt_hi >> 1, kk_lo = kt_lo >> 1;
    const bf16_t* ksrc = KT0 + (size_t)khead * 4096 + tid * 8;
    const bf16_t* vsrc = Vt0 + (size_t)(vrow >> 5) * 1024 + tid * 8;
    const int kb0 = (int)(tokb >> 5);
    { const size_t o0 = (size_t)(kb0 + 2 * kk_hi) * 32768, o1 = o0 + 32768;
      const u32x4 k0 = *(const u32x4*)(ksrc + o0), v0 = *(const u32x4*)(vsrc + o0), k1 = *(const u32x4*)(ksrc + o1), v1 = *(const u32x4*)(vsrc + o1);
      *(PG8_LAS u32x4*)(lds + tid * 16) = k0; *(PG8_LAS u32x4*)(lds + 8192 + tid * 16) = v0; *(PG8_LAS u32x4*)(lds + 16384 + tid * 16) = k1; *(PG8_LAS u32x4*)(lds + 24576 + tid * 16) = v1;
      if (MODE == 0 && tid < 16) *(PG8_LAS f32x4*)(lds + 32768 + tid * 16) = *(const f32x4*)(cb + kk_hi * 64 + tid * 4); }
    __syncthreads();
    bool done = false;
    int cur = 0;
    for (int kk = kk_hi; kk >= kk_lo; --kk, cur ^= 1) {
        const int kkn = kk > kk_lo ? kk - 1 : kk_lo;
        const size_t on0 = (size_t)(kb0 + 2 * kkn) * 32768, on1 = on0 + 32768;
        const u32x4 kpre0 = *(const u32x4*)(ksrc + on0), vpre0 = *(const u32x4*)(vsrc + on0), kpre1 = *(const u32x4*)(ksrc + on1), vpre1 = *(const u32x4*)(vsrc + on1);
        f32x4 bpre = {0.f, 0.f, 0.f, 0.f};
        if (MODE == 0 && tid < 16) bpre = *(const f32x4*)(cb + kkn * 64 + tid * 4);
        PG8_LAS unsigned char* bufp = lds + cur * PBUF;
#pragma unroll 1
        for (int sub = 1; sub >= 0; --sub) {
        const int kt = 2 * kk + sub;
        PG8_LAS unsigned char* bufc = bufp + sub * 16384;
        if (kt <= qt && kt >= ktmin && !done) {
        const int s0 = kt * 32; (void)s0;
        f32x4 cv[4];
        if (MODE == 0) {
#pragma unroll
            for (int a = 0; a < 4; ++a) cv[a] = *(const PG8_LAS f32x4*)(bufp + 32768 + sub * 128 + (8 * a + 4 * half) * 4);
        }
        bf16x8 kf[8];
#pragma unroll
        for (int s = 0; s < 8; ++s) kf[s] = *(const PG8_LAS bf16x8*)(bufc + s * 1024 + half * 512 + q * 16);
        f32x16 sa = ATT_ZERO16;
        __builtin_amdgcn_s_setprio(1);
#pragma unroll
        for (int s = 0; s < 8; ++s) sa = __builtin_amdgcn_mfma_f32_32x32x16_bf16(kf[s], qf[s], sa, 0, 0, 0);
        __builtin_amdgcn_s_setprio(0);
        bf16x8 vf[4][2];
#pragma unroll
        for (int dt = 0; dt < 4; ++dt)
#pragma unroll
            for (int s2 = 0; s2 < 2; ++s2) vf[dt][s2] = *(const PG8_LAS bf16x8*)(bufc + 8192 + dt * 2048 + s2 * 1024 + half * 512 + q * 16);
        f32x16 p;
        if (MODE == 0) {
#pragma unroll
            for (int a = 0; a < 4; ++a)
#pragma unroll
                for (int e = 0; e < 4; ++e) sa[4 * a + e] += (cref - cv[a][e]) * LOG2E;
            if (kt == qt) {
#pragma unroll
                for (int i = 0; i < 16; ++i) { const int key = (i & 3) + 8 * (i >> 2) + 4 * half; if (key > q) sa[i] = NEG; }
            }
            float tm = sa[0];
#pragma unroll
            for (int i = 1; i < 16; ++i) tm = fmaxf(tm, sa[i]);
            tm = half_max(tm);
            const float mn = fmaxf(mrun, tm);
            if (!__all(mn == mrun)) {
                const float alpha = ex2(mrun - mn); mrun = mn; lrun *= alpha;
#pragma unroll
                for (int dt = 0; dt < 4; ++dt) o[dt] = o[dt] * alpha;
            }
            float ps = 0.f;
#pragma unroll
            for (int i = 0; i < 16; ++i) { p[i] = ex2(sa[i] - mrun); ps += p[i]; }
            ps = half_sum(ps); lrun += ps;
        } else {
            f32x16 l1;
#pragma unroll
            for (int i = 0; i < 16; ++i) { const float z = sa[i], u = lg2(1.0f + ex2(-fabsf(z))), sp = fmaxf(z, 0.f) + u; l1[i] = -sp; p[i] = z - sp; }
            const bool diag = (kt == qt);
            if (diag) {
#pragma unroll
                for (int i = 0; i < 16; ++i) { const int key = (i & 3) + 8 * (i >> 2) + 4 * half; if (key >= q) l1[i] = 0.f; }
            }
            float R[4], ex[16];
#pragma unroll
            for (int a = 0; a < 4; ++a) { ex[4 * a + 3] = 0.f; ex[4 * a + 2] = l1[4 * a + 3]; ex[4 * a + 1] = l1[4 * a + 2] + ex[4 * a + 2]; ex[4 * a + 0] = l1[4 * a + 1] + ex[4 * a + 1]; R[a] = l1[4 * a] + ex[4 * a]; }
            float Ro[4], T[4];
#pragma unroll
            for (int a = 0; a < 4; ++a) { Ro[a] = other_half(R[a], half); T[a] = R[a] + Ro[a]; }
            float suf[4]; suf[3] = 0.f; suf[2] = T[3]; suf[1] = T[2] + suf[2]; suf[0] = T[1] + suf[1];
#pragma unroll
            for (int a = 0; a < 4; ++a) { const float off = lrun + suf[a] + (half == 0 ? Ro[a] : 0.f);
#pragma unroll
                for (int e = 0; e < 4; ++e) p[4 * a + e] = ex2(p[4 * a + e] + off + ex[4 * a + e]); }
            if (diag) {
#pragma unroll
                for (int i = 0; i < 16; ++i) { const int key = (i & 3) + 8 * (i >> 2) + 4 * half; if (key >= q) p[i] = 0.f; }
            }
            lrun += T[0] + suf[0];
        }
        const bf16x8 pb0 = pack8(p, 0), pb1 = pack8(p, 1);
        __builtin_amdgcn_s_setprio(1);
#pragma unroll
        for (int dt = 0; dt < 4; ++dt) { o[dt] = __builtin_amdgcn_mfma_f32_32x32x16_bf16(vf[dt][0], pb0, o[dt], 0, 0, 0); o[dt] = __builtin_amdgcn_mfma_f32_32x32x16_bf16(vf[dt][1], pb1, o[dt], 0, 0, 0); }
        __builtin_amdgcn_s_setprio(0);
        if (MODE == 1) { if (__all(lrun < thr2)) done = true; }
        }
        }
        { PG8_LAS unsigned char* bn = lds + (cur ^ 1) * PBUF;
          *(PG8_LAS u32x4*)(bn + tid * 16) = kpre0; *(PG8_LAS u32x4*)(bn + 8192 + tid * 16) = vpre0; *(PG8_LAS u32x4*)(bn + 16384 + tid * 16) = kpre1; *(PG8_LAS u32x4*)(bn + 24576 + tid * 16) = vpre1;
          if (MODE == 0 && tid < 16) *(PG8_LAS f32x4*)(bn + 32768 + tid * 16) = bpre; }
        if (MODE == 1) { if (__syncthreads_and(done ? 1 : 0)) break; }
        else __syncthreads();
    }
    const float inv = (MODE == 0) ? __builtin_amdgcn_rcpf(lrun) : 1.0f;
    const bf16_t* gp = P0 + (tokb + t0 + q) * 2048 + 1024 + ocol + 4 * half;
    bf16_t* op = MIX0 + (tokb + t0 + q) * 1024 + ocol + 4 * half;
#pragma unroll
    for (int dt = 0; dt < 4; ++dt)
#pragma unroll
        for (int a = 0; a < 4; ++a) {
            const u32x2 gw = *(const u32x2*)(gp + dt * 32 + 8 * a);
            const float g0 = __uint_as_float(gw.x << 16), g1 = __uint_as_float(gw.x & 0xffff0000u), g2 = __uint_as_float(gw.y << 16), g3 = __uint_as_float(gw.y & 0xffff0000u);
            u32x2 w; w.x = cvtpk(o[dt][4 * a + 0] * inv * g0, o[dt][4 * a + 1] * inv * g1); w.y = cvtpk(o[dt][4 * a + 2] * inv * g2, o[dt][4 * a + 3] * inv * g3);
            *(u32x2*)(op + dt * 32 + 8 * a) = w;
        }
}

__device__ __forceinline__ void dil_tile(int g, int dshift, int b, int h, int r, int i0, int nq, int T0, const bf16_t* __restrict__ P1, const bf16_t* __restrict__ KT1, const bf16_t* __restrict__ Vt1, float slope2, PG8_LAS bf16_t* og, PG8_LAS float* lse, int lane, float skip2) {
    const int qraw = lane & 31, half = lane >> 5, q = qraw < nq ? qraw : nq - 1;
    const int dil = 1 << dshift, L = S >> dshift;
    const size_t tokb = (size_t)b * S;
    const int iq = i0 + q, tq = (iq << dshift) + r;
    bf16x8 qf[4];
    { const size_t pq = tokb + (size_t)r * L + i0;
      const bf16_t* qp = P1 + (size_t)(pq >> 5) * 49152 + (size_t)(g * 8 + h) * 2048 + half * 256 + ((int)(pq & 31) + q) * 8;
#pragma unroll
      for (int s = 0; s < 4; ++s) qf[s] = *(const bf16x8*)(qp + 512 * s); }
    f32x16 o[2] = {ATT_ZERO16, ATT_ZERO16};
    float mrun = NEG, lrun = 0.f;
    const float sl = slope2 * (float)dil;
    const int d0i = iq - (i0 & ~31) + 128 - 4 * half; const float t0a = -sl * (float)d0i;
    const int ib = i0 & ~31;
    const bf16_t* kbase = KT1 + (size_t)(g * 8 + h) * 2048 + half * 256 + qraw * 8;
    const size_t pb0 = tokb + (size_t)r * L;
    bf16x8 kn[4];
    { const bf16_t* kp = kbase + (size_t)((pb0 + ib) >> 5) * 49152;
#pragma unroll
      for (int s = 0; s < 4; ++s) kn[s] = *(const bf16x8*)(kp + 512 * s); }
    for (int kt = 4; kt >= 0; --kt) {
        const int j0 = ib - 128 + 32 * kt;
        if (j0 < 0) break;
        if (sl * (float)((i0 - ib) + 97 - 32 * kt) > skip2) break;
        bf16x8 kf[4];
#pragma unroll
        for (int s = 0; s < 4; ++s) kf[s] = kn[s];
        { const int jn = j0 >= 32 ? j0 - 32 : 0;
          const bf16_t* kp = kbase + (size_t)((pb0 + jn) >> 5) * 49152;
#pragma unroll
          for (int s = 0; s < 4; ++s) kn[s] = *(const bf16x8*)(kp + 512 * s); }
        f32x16 sa;
        { const float base = t0a + sl * (float)(32 * kt);
#pragma unroll
          for (int i = 0; i < 16; ++i) sa[i] = base + sl * (float)((i & 3) + 8 * (i >> 2)); }
        __builtin_amdgcn_s_setprio(1);
#pragma unroll
        for (int s = 0; s < 4; ++s) sa = __builtin_amdgcn_mfma_f32_32x32x16_bf16(kf[s], qf[s], sa, 0, 0, 0);
        __builtin_amdgcn_s_setprio(0);
        bf16x8 vf[2][2];
        { const bf16_t* vp = Vt1 + (size_t)g * 512 * 32768 + (size_t)((pb0 + j0) >> 5) * 16384 + (h * 2) * 1024 + half * 256 + qraw * 8;
#pragma unroll
          for (int dt = 0; dt < 2; ++dt)
#pragma unroll
              for (int s2 = 0; s2 < 2; ++s2) vf[dt][s2] = *(const bf16x8*)(vp + dt * 1024 + s2 * 512); }
        { const int dmin = (i0 - ib) + 97 - 32 * kt, dmax = (i0 - ib) + nq + 127 - 32 * kt;
          if (dmin < 0 || dmax > 128) {
#pragma unroll
              for (int i = 0; i < 16; ++i) { const int dist = d0i - 32 * kt - ((i & 3) + 8 * (i >> 2)); if ((unsigned)dist > 128u) sa[i] = NEG; }
          } }
        float tm = sa[0];
#pragma unroll
        for (int i = 1; i < 16; ++i) tm = fmaxf(tm, sa[i]);
        tm = half_max(tm);
        const float mn = fmaxf(mrun, tm), alpha = ex2(mrun - mn); mrun = mn;
        f32x16 p; float ps = 0.f;
#pragma unroll
        for (int i = 0; i < 16; ++i) { p[i] = ex2(sa[i] - mn); ps += p[i]; }
        ps = half_sum(ps); lrun = lrun * alpha + ps;
        o[0] = o[0] * alpha; o[1] = o[1] * alpha;
        const bf16x8 pb0 = pack8(p, 0), pb1 = pack8(p, 1);
        __builtin_amdgcn_s_setprio(1);
#pragma unroll
        for (int dt = 0; dt < 2; ++dt) { o[dt] = __builtin_amdgcn_mfma_f32_32x32x16_bf16(vf[dt][0], pb0, o[dt], 0, 0, 0); o[dt] = __builtin_amdgcn_mfma_f32_32x32x16_bf16(vf[dt][1], pb1, o[dt], 0, 0, 0); }
        __builtin_amdgcn_s_setprio(0);
    }
    if (qraw < nq) {
        const float inv = __builtin_amdgcn_rcpf(lrun); const int tl = tq - T0;
        if (half == 0) lse[tl] = mrun + lg2(lrun);
        const int swz = (tl ^ (tl >> 2) ^ (tl >> 4)) & 7;
        PG8_LAS bf16_t* dst = og + (size_t)tl * 64 + 4 * half;
#pragma unroll
        for (int dt = 0; dt < 2; ++dt)
#pragma unroll
            for (int a = 0; a < 4; ++a) { u32x2 w; w.x = cvtpk(o[dt][4 * a + 0] * inv, o[dt][4 * a + 1] * inv); w.y = cvtpk(o[dt][4 * a + 2] * inv, o[dt][4 * a + 3] * inv);
                *(PG8_LAS u32x2*)(dst + (((4 * dt + a) ^ swz) << 3)) = w; }
    }
}
}
#ifndef PH_MASK
#define PH_MASK 127
#endif
#ifndef WGM_P1
#define WGM_P1 4
#endif
#ifndef WGM_P4
#define WGM_P4 2
#endif
#ifndef REP0
#define REP0 1
#endif
#ifndef REP1
#define REP1 1
#endif
#ifndef REP3
#define REP3 1
#endif
#ifndef REP4
#define REP4 1
#endif
#ifndef REP6
#define REP6 1
#endif
#ifndef REP2
#define REP2 1
#endif
#ifndef REP5
#define REP5 1
#endif
#define LAS __attribute__((address_space(3)))
#define GAS __attribute__((address_space(1)))
typedef unsigned short bf16;
constexpr int NB = 2, SEQ = 16384, MTOK = NB * SEQ, DM = 1024;
constexpr int EVEN_IN = 4100, ODD_IN = 5120;
constexpr size_t MiB = 1u << 20;
constexpr size_t WS_CTL = 0;
constexpr size_t WS_W0T = 2 * MiB;
constexpr size_t WS_W0VT = 8 * MiB;
constexpr size_t WS_W0O = 10 * MiB;
constexpr size_t WS_W1T = 12 * MiB;
constexpr size_t WS_W1VT = 19 * MiB;
constexpr size_t WS_W1O = 22 * MiB;
constexpr size_t WS_SS0 = 24 * MiB, WS_SS1 = WS_SS0 + 131072, WS_LOGF = WS_SS1 + 131072, WS_CUM = WS_LOGF + 524288;
constexpr size_t WS_XB = 32 * MiB;
constexpr size_t WS_P = 96 * MiB;
constexpr size_t WS_KT = 224 * MiB;
constexpr size_t WS_VT0 = 320 * MiB, WS_MIX0 = 384 * MiB;
constexpr size_t WS_VT1 = 320 * MiB;
constexpr size_t WS_MIX1 = 448 * MiB;
constexpr size_t WS_END = 480 * MiB;
constexpr int LDS_BYTES = 148480, EPI_SCR_OFF = 131072, MISC_OFF = 147456;
constexpr int CW_BAR = 4096;

#define XB_TMO      128
#define XB_XCNT(j)  (256  + 64 * (j))
#define XB_XSUB(j)  (1280 + 64 * (j))
#define XB_XGEN(j)  (2304 + 64 * (j))
#define XB_TOP      3328
#define XB_TOPGEN   3392
#define XCD_BAR_WORDS 3456
#define XB_SPIN_CAP (1u << 18)

__device__ __forceinline__ unsigned xb_ld(unsigned* p)              { return __hip_atomic_load(p, __ATOMIC_RELAXED, __HIP_MEMORY_SCOPE_AGENT); }
__device__ __forceinline__ unsigned xb_add(unsigned* p, unsigned v) { return __hip_atomic_fetch_add(p, v, __ATOMIC_RELAXED, __HIP_MEMORY_SCOPE_AGENT); }
__device__ __forceinline__ unsigned xb_xcc_id() { return (unsigned)__builtin_amdgcn_s_getreg((3 << 11) | 20) & 0xFu; }
#define XB_SPIN(cond, bar) do { unsigned _sp = 0; while (cond) { __builtin_amdgcn_s_sleep(1); \
    if ((++_sp & 255u) == 0u) { if (xb_ld(&(bar)[XB_TMO])) break; if (_sp > XB_SPIN_CAP) { atomicAdd(&(bar)[XB_TMO], 1u); break; } } } } while (0)

struct XcdBarrier {
    unsigned* bar; unsigned x;
    volatile LAS unsigned* st;
};

__device__ __forceinline__ XcdBarrier xcd_barrier_post(unsigned* bar, volatile LAS unsigned* st) {
    XcdBarrier b; b.bar = bar; b.x = xb_xcc_id(); b.st = st;
    if (threadIdx.x == 0) (void)xb_add(&bar[XB_XCNT(b.x)], 1u);
    return b;
}
__device__ __forceinline__ void xcd_barrier_complete(unsigned* bar, unsigned x, unsigned& nloc, unsigned& nx) {
    const unsigned G = gridDim.x * gridDim.y * gridDim.z;
    unsigned sum, cnt, mine, sp = 0u;
    for (;;) {
        sum = 0u; cnt = 0u; mine = 0u;
#pragma unroll
        for (unsigned j = 0; j < 16; ++j) { const unsigned c = xb_ld(&bar[XB_XCNT(j)]); sum += c; cnt += (c > 0u) ? 1u : 0u; mine = (j == x) ? c : mine; }
        if (sum == G) break;
        __builtin_amdgcn_s_sleep(1);
        if ((++sp & 255u) == 0u) { if (xb_ld(&bar[XB_TMO])) break; if (sp > XB_SPIN_CAP) { atomicAdd(&bar[XB_TMO], 1u); break; } }
    }
    nloc = mine > 0u ? mine : 1u; nx = cnt > 0u ? cnt : 1u;
}

__device__ __forceinline__ void xcd_barrier(const XcdBarrier& b) {
    asm volatile("s_waitcnt vmcnt(0)" ::: "memory");
    __syncthreads();
    if (threadIdx.x == 0) {
        unsigned* bar = b.bar;
        __builtin_amdgcn_s_waitcnt(0);
        unsigned nloc = b.st[0], nx = b.st[1];
        if (nloc == 0u) { xcd_barrier_complete(bar, b.x, nloc, nx); b.st[0] = nloc; b.st[1] = nx; }
        const unsigned old = xb_add(&bar[XB_XSUB(b.x)], 1u);
        const unsigned gen = old / nloc;
        if (old + 1u == (gen + 1u) * nloc) {
            __builtin_amdgcn_fence(__ATOMIC_RELEASE, "agent");
            asm volatile("s_waitcnt vmcnt(0)" ::: "memory");
            const unsigned og = xb_add(&bar[XB_TOP], 1u);
            const unsigned tg = og / nx;
            if (og + 1u == (tg + 1u) * nx) xb_add(&bar[XB_TOPGEN], 1u);
            else XB_SPIN(xb_ld(&bar[XB_TOPGEN]) == tg, bar);
            __builtin_amdgcn_fence(__ATOMIC_ACQUIRE, "agent");
            xb_add(&bar[XB_XGEN(b.x)], 1u);
            asm volatile("s_waitcnt vmcnt(0)" ::: "memory");
        } else {
            XB_SPIN(xb_ld(&bar[XB_XGEN(b.x)]) == gen, bar);
            __builtin_amdgcn_fence(__ATOMIC_ACQUIRE, "agent");
            asm volatile("s_waitcnt vmcnt(0)" ::: "memory");
        }
    }
    __syncthreads();
}

__device__ __forceinline__ float wave_sum(float v) {
#pragma unroll
    for (int o = 1; o < 64; o <<= 1) v += __shfl_xor(v, o);
    return v;
}
__device__ __forceinline__ float wave_max(float v) {
#pragma unroll
    for (int o = 1; o < 64; o <<= 1) v = fmaxf(v, __shfl_xor(v, o));
    return v;
}
struct TItem { const float* W; const float* gain; bf16* WT; int ldw, c0, K, row_off, nblk, r; };
__device__ __forceinline__ void titem_load(const TItem& t, int lane, pg8::f32x4 (&v)[8], float (&gv)[8]) {
    const int kb = t.r / t.nblk, nb = t.r % t.nblk, k0 = 64 * kb, n0 = 32 * nb;
#pragma unroll
    for (int i = 0; i < 8; ++i) { const int kk = (lane >> 3) + 8 * i; v[i] = *(const pg8::f32x4*)(t.W + (size_t)(k0 + kk) * t.ldw + t.c0 + n0 + 4 * (lane & 7)); gv[i] = t.gain ? t.gain[k0 + kk] : 1.0f; }
}
__device__ __forceinline__ void titem_store(const TItem& t, int lane, const pg8::f32x4 (&v)[8], const float (&gv)[8], LAS float* scr) {
    const int kb = t.r / t.nblk, nb = t.r % t.nblk, k0 = 64 * kb, n0 = 32 * nb;
#pragma unroll
    for (int i = 0; i < 8; ++i) { const int kk = (lane >> 3) + 8 * i; LAS float* d = scr + kk * 33 + 4 * (lane & 7); d[0] = v[i][0] * gv[i]; d[1] = v[i][1] * gv[i]; d[2] = v[i][2] * gv[i]; d[3] = v[i][3] * gv[i]; }
    asm volatile("s_waitcnt lgkmcnt(0)" ::: "memory");
    const int c = lane & 7;
#pragma unroll
    for (int j = 0; j < 4; ++j) { const int n = (lane >> 3) + 8 * j; const LAS float* s = scr + (8 * c) * 33 + n;
        pg8::u32x4 o; o.x = pg8::cvtpk(s[0 * 33], s[1 * 33]); o.y = pg8::cvtpk(s[2 * 33], s[3 * 33]); o.z = pg8::cvtpk(s[4 * 33], s[5 * 33]); o.w = pg8::cvtpk(s[6 * 33], s[7 * 33]);
        *(pg8::u32x4*)(t.WT + (size_t)(t.row_off + n0 + n) * t.K + k0 + 8 * c) = o; }
    asm volatile("s_waitcnt lgkmcnt(0)" ::: "memory");
}

struct Args { const float* in[12]; float* out; unsigned char* ws; };

__global__ void __launch_bounds__(512, 2) mk_fwd(Args args) {
    extern __shared__ __attribute__((aligned(16))) unsigned char lds_raw[];
    cg::grid_group grid = cg::this_grid();
    LAS unsigned char* lds = (LAS unsigned char*)lds_raw;
    const int wave = __builtin_amdgcn_readfirstlane((int)threadIdx.x >> 6);
#define PHASE_IDS int tid = threadIdx.x; asm volatile("" : "+v"(tid)); const int lane = tid & 63; (void)lane; PHASE_PTRS
    const int G = gridDim.x, gw = blockIdx.x * 8 + wave, NGW = G * 8;
#define PHASE_PTRS const __attribute__((address_space(4))) Args* ap_ = (const __attribute__((address_space(4))) Args*)__builtin_amdgcn_kernarg_segment_ptr(); asm volatile("" : "+s"(ap_)); unsigned char* ws = ap_->ws; const float* x = ap_->in[0]; const float* even_norm = ap_->in[1]; const float* even_w_in = ap_->in[2]; const float* even_b_f = ap_->in[3]; const float* even_qg = ap_->in[4]; const float* even_kg = ap_->in[5]; const float* even_w_out = ap_->in[6]; const float* odd_norm = ap_->in[7]; const float* odd_w_in = ap_->in[8]; const float* odd_qg = ap_->in[9]; const float* odd_kg = ap_->in[10]; const float* odd_w_out = ap_->in[11]; float* out = ap_->out; bf16* W0T = (bf16*)(ws + WS_W0T); bf16* W0VT = (bf16*)(ws + WS_W0VT); bf16* W0O = (bf16*)(ws + WS_W0O); bf16* W1T = (bf16*)(ws + WS_W1T); bf16* W1VT = (bf16*)(ws + WS_W1VT); bf16* W1O = (bf16*)(ws + WS_W1O); float* SS0 = (float*)(ws + WS_SS0); float* SS1 = (float*)(ws + WS_SS1); float* LOGF = (float*)(ws + WS_LOGF); float* CUM = (float*)(ws + WS_CUM); bf16* XB = (bf16*)(ws + WS_XB); bf16* PB = (bf16*)(ws + WS_P); bf16* KT = (bf16*)(ws + WS_KT); bf16* VT0 = (bf16*)(ws + WS_VT0); bf16* MIX0 = (bf16*)(ws + WS_MIX0); bf16* VT1 = (bf16*)(ws + WS_VT1); bf16* MIX1 = (bf16*)(ws + WS_MIX1); unsigned* CTL = (unsigned*)(ws + WS_CTL);
    { PHASE_IDS
    if (tid < 64) ((volatile LAS unsigned*)(lds + MISC_OFF))[tid] = 0u;
    __syncthreads();
    if (blockIdx.x == 0) {
#pragma unroll
        for (int k = 0; k < 16; ++k) CTL[tid + 512 * k] = 0u;
    }
    }
#define XBAR() do { XcdBarrier b_; b_.bar = (unsigned*)(args.ws + WS_CTL) + CW_BAR; b_.x = xb_xcc_id(); b_.st = (volatile LAS unsigned*)(lds + MISC_OFF); xcd_barrier(b_); } while (0)

#if PH_MASK & 1
    { PHASE_IDS
#if REP0 > 1
      for (int rep0 = 0; rep0 < REP0; ++rep0) { if (rep0) __syncthreads();
#else
      {
#endif
        LAS float* scr = (LAS float*)(lds + wave * 16384);
        LAS float* gwf = (LAS float*)(lds + 131072);
        for (int k = tid; k < 1024; k += 512) { const pg8::f32x4 w = *(const pg8::f32x4*)(even_w_in + (size_t)k * EVEN_IN + 1536); const float gk = even_norm[k];
            *(LAS pg8::f32x4*)(gwf + 4 * k) = w * gk; }
        constexpr int I512 = 16 * 16, I1024 = 16 * 32, I1536 = 16 * 48, IO1 = 8 * 32;
        constexpr int NITEMS = 6 * I512 + I1024   + I1024   + 3 * I1536 + I512   + IO1;
        auto decode = [&](int it) -> TItem {
            int r = it;
            if (r < I512) return TItem{even_w_in, even_norm, W0T, EVEN_IN, 0, 1024, 0, 16, r}; r -= I512;
            if (r < I512) return TItem{even_w_in, even_norm, W0T, EVEN_IN, 512, 1024, 512, 16, r}; r -= I512;
            if (r < I512) return TItem{even_w_in, even_norm, W0T, EVEN_IN, 1540, 1024, 1024, 16, r}; r -= I512;
            if (r < I512) return TItem{even_w_in, even_norm, W0T, EVEN_IN, 2052, 1024, 1536, 16, r}; r -= I512;
            if (r < I1024) return TItem{even_w_in, even_norm, W0T, EVEN_IN, 3076, 1024, 2048, 32, r}; r -= I1024;
            if (r < I512) return TItem{even_w_in, even_norm, W0VT, EVEN_IN, 1024, 1024, 0, 16, r}; r -= I512;
            if (r < I512) return TItem{even_w_in, even_norm, W0VT, EVEN_IN, 2564, 1024, 512, 16, r}; r -= I512;
            if (r < I1024) return TItem{even_w_out, nullptr, W0O, 1024, 0, 1024, 0, 32, r}; r -= I1024;
            if (r < I1536) return TItem{odd_w_in, odd_norm, W1T, ODD_IN, 0, 1024, 0, 48, r}; r -= I1536;
            if (r < I1536) return TItem{odd_w_in, odd_norm, W1T, ODD_IN, 1536, 1024, 1536, 48, r}; r -= I1536;
            if (r < I512) return TItem{odd_w_in, odd_norm, W1T, ODD_IN, 4608, 1024, 3072, 16, r}; r -= I512;
            if (r < I1536) return TItem{odd_w_in, odd_norm, W1VT, ODD_IN, 3072, 1024, 0, 48, r}; r -= I1536;
            return TItem{odd_w_out, nullptr, W1O, 1024, 0, 512, 0, 32, r};
        };
        for (int it = gw; it < NITEMS; it += 3 * NGW) {
            const int it1 = it + NGW, it2 = it + 2 * NGW; const bool h1 = it1 < NITEMS, h2 = it2 < NITEMS;
            const TItem t0 = decode(it), t1 = decode(h1 ? it1 : it), t2 = decode(h2 ? it2 : it);
            pg8::f32x4 v0[8], v1[8], v2[8]; float g0[8], g1[8], g2[8];
            titem_load(t0, lane, v0, g0);
            if (h1) titem_load(t1, lane, v1, g1);
            if (h2) titem_load(t2, lane, v2, g2);
            titem_store(t0, lane, v0, g0, scr);
            if (h1) titem_store(t1, lane, v1, g1, scr);
            if (h2) titem_store(t2, lane, v2, g2, scr);
        }
        for (int i = blockIdx.x * 512 + tid; i < MTOK; i += G * 512) SS1[i] = 0.f;
        __syncthreads();
        const float bf0 = even_b_f[0], bf1 = even_b_f[1], bf2 = even_b_f[2], bf3 = even_b_f[3];
        LAS float* lf = (LAS float*)(lds + wave * 16384 + 12288);
        for (int ck = blockIdx.x; ck < MTOK / 128; ck += G) {
            pg8::f32x4 vn[4][4];
#pragma unroll
            for (int q = 0; q < 4; ++q)
#pragma unroll
                for (int j = 0; j < 4; ++j) vn[q][j] = ((const pg8::f32x4*)(x + (size_t)(ck * 128 + wave * 16 + q) * DM) + lane)[64 * j];
#pragma unroll 1
            for (int r4 = 0; r4 < 16; r4 += 4) {
                const int m0 = ck * 128 + wave * 16 + r4;
                pg8::f32x4 v[4][4];
#pragma unroll
                for (int q = 0; q < 4; ++q)
#pragma unroll
                    for (int j = 0; j < 4; ++j) v[q][j] = vn[q][j];
                { const int mn = ck * 128 + wave * 16 + (r4 < 12 ? r4 + 4 : 12);
#pragma unroll
                  for (int q = 0; q < 4; ++q)
#pragma unroll
                      for (int j = 0; j < 4; ++j) vn[q][j] = ((const pg8::f32x4*)(x + (size_t)(mn + q) * DM) + lane)[64 * j]; }
                float s[4] = {0.f, 0.f, 0.f, 0.f}, d[4][4] = {{0.f, 0.f, 0.f, 0.f}, {0.f, 0.f, 0.f, 0.f}, {0.f, 0.f, 0.f, 0.f}, {0.f, 0.f, 0.f, 0.f}};
#pragma unroll
                for (int j = 0; j < 4; ++j) {
#pragma unroll
                    for (int e = 0; e < 4; ++e) { const pg8::f32x4 w = *(const LAS pg8::f32x4*)(gwf + 4 * (256 * j + 4 * lane + e));
#pragma unroll
                        for (int q = 0; q < 4; ++q) { const float xv = v[q][j][e]; s[q] += xv * xv; d[q][0] += xv * w[0]; d[q][1] += xv * w[1]; d[q][2] += xv * w[2]; d[q][3] += xv * w[3]; } }
#pragma unroll
                    for (int q = 0; q < 4; ++q) ((unsigned long long*)(XB + (size_t)(m0 + q) * DM) + lane)[64 * j] = (unsigned long long)pg8::cvtpk(v[q][j][0], v[q][j][1]) | ((unsigned long long)pg8::cvtpk(v[q][j][2], v[q][j][3]) << 32);
                }
#pragma unroll
                for (int o = 1; o < 64; o <<= 1) {
#pragma unroll
                    for (int q = 0; q < 4; ++q) { s[q] += __shfl_xor(s[q], o); d[q][0] += __shfl_xor(d[q][0], o); d[q][1] += __shfl_xor(d[q][1], o); d[q][2] += __shfl_xor(d[q][2], o); d[q][3] += __shfl_xor(d[q][3], o); } }
                if (lane < 4) {
                    const float sq = lane == 0 ? s[0] : (lane == 1 ? s[1] : (lane == 2 ? s[2] : s[3]));
                    float dd[4];
#pragma unroll
                    for (int hh = 0; hh < 4; ++hh) dd[hh] = lane == 0 ? d[0][hh] : (lane == 1 ? d[1][hh] : (lane == 2 ? d[2][hh] : d[3][hh]));
                    SS0[m0 + lane] = sq;
                    const float rr = 1.0f / sqrtf(sq * (1.0f / 1024.0f) + 1e-6f);
                    const float f0 = rr * dd[0] + bf0, f1 = rr * dd[1] + bf1, f2 = rr * dd[2] + bf2, f3 = rr * dd[3] + bf3;
                    lf[(r4 + lane) * 4 + 0] = fminf(f0, 0.f) - log1pf(expf(-fabsf(f0)));
                    lf[(r4 + lane) * 4 + 1] = fminf(f1, 0.f) - log1pf(expf(-fabsf(f1)));
                    lf[(r4 + lane) * 4 + 2] = fminf(f2, 0.f) - log1pf(expf(-fabsf(f2)));
                    lf[(r4 + lane) * 4 + 3] = fminf(f3, 0.f) - log1pf(expf(-fabsf(f3)));
                }
            }
            __syncthreads();
            if (wave < 4) {
                const int hh = wave, bb = ck >> 7, cl = ck & 127;
                float v0 = *(const LAS float*)(lds + (lane >> 4) * 16384 + 12288 + ((lane & 15) * 4 + hh) * 4);
                float v1 = *(const LAS float*)(lds + (4 + (lane >> 4)) * 16384 + 12288 + ((lane & 15) * 4 + hh) * 4);
#pragma unroll
                for (int o = 1; o < 64; o <<= 1) { const float t0 = __shfl_up(v0, o), t1 = __shfl_up(v1, o); if (lane >= o) { v0 += t0; v1 += t1; } }
                const float tot0 = __shfl(v0, 63); v1 += tot0;
                float* dst = CUM + (size_t)(bb * 4 + hh) * SEQ + cl * 128;
                dst[lane] = v0; dst[64 + lane] = v1;
                if (lane == 63) LOGF[(bb * 4 + hh) * 128 + cl] = v1;
            }
            __syncthreads();
        }
      }
    }
#endif
    grid.sync();
    { PHASE_IDS (void)tid; (void)xcd_barrier_post(CTL + CW_BAR, (volatile LAS unsigned*)(lds + MISC_OFF)); }

#if PH_MASK & 2
    { PHASE_IDS
        for (int ck = blockIdx.x; ck < MTOK / 128; ck += G) {
            if (wave < 4) {
                const int hh = wave, bb = ck >> 7, cl = ck & 127; const float* tt = LOGF + (bb * 4 + hh) * 128;
                float a = (lane < cl ? tt[lane] : 0.f) + (64 + lane < cl ? tt[64 + lane] : 0.f);
                a = wave_sum(a);
                float* dst = CUM + (size_t)(bb * 4 + hh) * SEQ + cl * 128;
                dst[lane] += a; dst[64 + lane] += a;
            }
        }
        { pg8::Gemm g{XB, W0T, MTOK, 3072, 1024, 1024, 0}; pg8::StaticOrder S; S.init(MTOK, 3072, G, (int)blockIdx.x, WGM_P1);
          pg8::EpiProj E{PB, 2048, SS0, 2, 2, 2, 2, 1, even_qg, even_kg, 0.08838834764831845f * 1.4426950408889634f, (LAS float*)(lds + EPI_SCR_OFF), KT, 8, nullptr};
          pg8::gemm_phase<pg8::EpiProj, pg8::StaticOrder, true, true>(lds, g, S, E); }
        { pg8::Gemm g{W0VT, XB, 1024, MTOK, 1024, 1024, 0}; pg8::StaticOrder S; S.init(1024, MTOK, G, (int)blockIdx.x);
          pg8::EpiVt E{VT0, 1024, SS0, 0};
          pg8::gemm_phase<pg8::EpiVt, pg8::StaticOrder, true, true>(lds, g, S, E); }
#if REP1 > 1
        { pg8::Gemm g{XB, W0T, MTOK, 3072, 1024, 1024, 0}; pg8::StaticOrder S; S.init(MTOK, 3072, G, (int)blockIdx.x, WGM_P1);
          pg8::EpiProj E{PB, 2048, SS0, 2, 2, 2, 2, 1, even_qg, even_kg, 0.08838834764831845f * 1.4426950408889634f, (LAS float*)(lds + EPI_SCR_OFF), KT, 8, nullptr};
          pg8::gemm_phase<pg8::EpiProj, pg8::StaticOrder, true, true>(lds, g, S, E); }
        { pg8::Gemm g{W0VT, XB, 1024, MTOK, 1024, 1024, 0}; pg8::StaticOrder S; S.init(1024, MTOK, G, (int)blockIdx.x);
          pg8::EpiVt E{VT0, 1024, SS0, 0};
          pg8::gemm_phase<pg8::EpiVt, pg8::StaticOrder, true, true>(lds, g, S, E); }
#endif
    }
#endif
    XBAR();

#if PH_MASK & 4
    { PHASE_IDS
        float mq = fmaxf(fabsf(even_qg[lane]), fabsf(even_qg[lane + 64])), mk = fmaxf(fabsf(even_kg[lane]), fabsf(even_kg[lane + 64]));
        mq = wave_max(mq); mk = wave_max(mk);
        const float boundFox = 2.0f * 11.313708498984761f * mq * mk + 30.0f, boundSb = 30.0f;
        const unsigned myx = xb_xcc_id() & 7u;
        LAS unsigned* slotw = (LAS unsigned*)(lds + 2 * 33024 + 64);
        for (int rep = 0; rep < REP2; ++rep) {
        for (unsigned xo = 0; xo < 8u; ++xo) {
            const unsigned xq = (myx + xo) & 7u;
            for (;;) {
                if (tid == 0) *slotw = atomicAdd(CTL + 64 * (1 + xq + 16 * rep), 1u);
                __syncthreads();
                const unsigned idx = *slotw;
                __syncthreads();
                if (idx >= 64u) break;
                const int grp = idx >> 4, r = idx & 15, b = r >> 3, qb = (int)xq * 8 + 7 - (r & 7);
                att::l0_block<0>(b, 3 - grp, qb, PB, KT, VT0, CUM, MIX0, boundFox, lds, tid, wave, lane);
            }
        }
        for (unsigned xo = 0; xo < 8u; ++xo) {
            const unsigned xq = (myx + xo) & 7u;
            for (;;) {
                unsigned idx = 0;
                if (lane == 0) idx = atomicAdd(CTL + 64 * (9 + xq + 16 * rep), 1u);
                idx = __builtin_amdgcn_readfirstlane(idx);
                if (idx >= 512u) break;
                const int hh = idx >> 7, r = idx & 127, b = r >> 6, qt = (int)xq * 64 + 63 - (r & 63);
                att::l0_item<1>(b, hh, qt, PB, KT, VT0, CUM, MIX0, boundSb, lane);
            }
        }
        }
    }
#endif
    XBAR();

#if PH_MASK & 8
    { PHASE_IDS
        pg8::Gemm g{MIX0, W0O, MTOK, 1024, 1024, 1024, 0}; pg8::StaticOrder S; S.init(MTOK, 1024, G, (int)blockIdx.x);
#if REP3 > 1
        { pg8::EpiOut0 E0{x, VT0, SS0}; pg8::gemm_phase<pg8::EpiOut0, pg8::StaticOrder, true, true>(lds, g, S, E0); }
#endif
        pg8::EpiOut0 E{x, XB, SS1};
        pg8::gemm_phase<pg8::EpiOut0, pg8::StaticOrder, true, true>(lds, g, S, E);
    }
#endif
    XBAR();

#if PH_MASK & 16
    { PHASE_IDS
        { pg8::Gemm g{XB, W1T, MTOK, 3584, 1024, 1024, 0}; pg8::StaticOrder S; S.init(MTOK, 3584, G, (int)blockIdx.x, WGM_P4);
          pg8::EpiProj E{PB + (size_t)48 * 1024 * 1024 - 1536, 512, SS1, 6, 6, 0, 0, 0, odd_qg, odd_kg, 0.125f * 1.4426950408889634f, (LAS float*)(lds + EPI_SCR_OFF), KT, 24, PB};
          pg8::gemm_phase<pg8::EpiProj, pg8::StaticOrder, true, true>(lds, g, S, E); }
#pragma unroll 1
        for (int gi = 0; gi < 3; ++gi) {
            const int dsh = 2 * gi;
            pg8::Gemm g{W1VT + (size_t)gi * 512 * 1024, XB, 512, MTOK, 1024, 1024 << dsh, dsh}; pg8::StaticOrder S; S.init(512, MTOK, G, (int)blockIdx.x);
            pg8::EpiVt E{VT1 + (size_t)gi * 512 * MTOK, 512, SS1, dsh};
            pg8::gemm_phase<pg8::EpiVt, pg8::StaticOrder, true, true>(lds, g, S, E);
        }
#if REP4 > 1
        { pg8::Gemm g{XB, W1T, MTOK, 3584, 1024, 1024, 0}; pg8::StaticOrder S; S.init(MTOK, 3584, G, (int)blockIdx.x, WGM_P4);
          pg8::EpiProj E{PB + (size_t)48 * 1024 * 1024 - 1536, 512, SS1, 6, 6, 0, 0, 0, odd_qg, odd_kg, 0.125f * 1.4426950408889634f, (LAS float*)(lds + EPI_SCR_OFF), KT, 24, PB};
          pg8::gemm_phase<pg8::EpiProj, pg8::StaticOrder, true, true>(lds, g, S, E); }
#pragma unroll 1
        for (int gi = 0; gi < 3; ++gi) {
            const int dsh = 2 * gi;
            pg8::Gemm g{W1VT + (size_t)gi * 512 * 1024, XB, 512, MTOK, 1024, 1024 << dsh, dsh}; pg8::StaticOrder S; S.init(512, MTOK, G, (int)blockIdx.x);
            pg8::EpiVt E{VT1 + (size_t)gi * 512 * MTOK, 512, SS1, dsh};
            pg8::gemm_phase<pg8::EpiVt, pg8::StaticOrder, true, true>(lds, g, S, E);
        }
#endif
    }
#endif
    XBAR();

#if PH_MASK & 32
    { PHASE_IDS
        LAS bf16* og_run = (LAS bf16*)lds; LAS bf16* og_cur = (LAS bf16*)(lds + 65536);
        LAS float* lse_run = (LAS float*)(lds + 131072); LAS float* lse_cur = lse_run + 512; LAS float* lse_tmp = lse_run + 1024;
        LAS unsigned* slotw = (LAS unsigned*)(lds + 131072 + 6144);
        float skip2;
        { const float mq1 = wave_max(fabsf(odd_qg[lane])), mk1 = wave_max(fabsf(odd_kg[lane])); skip2 = (2.0f * 8.0f * mq1 * mk1 + 30.0f) * 1.4426950408889634f; }
        const unsigned myx = xb_xcc_id() & 7u;
        for (int rep = 0; rep < REP5; ++rep)
        for (unsigned xo = 0; xo < 8u; ++xo) {
          const unsigned xq = (myx + xo) & 7u;
          for (;;) {
            if (tid == 0) *slotw = atomicAdd(CTL + 64 * (40 + xq + 8 * rep), 1u);
            __syncthreads();
            const unsigned slot = *slotw;
            __syncthreads();
            if (slot >= 64u) break;
            const int bh = (int)xq * 2 + (int)(slot >> 5), tb = slot & 31, h = bh & 7, b = bh >> 3, T0 = tb * 512;
#pragma unroll 1
            for (int j = 0; j < 6; ++j) {
                if (j == 4) {
                    __syncthreads();
#pragma unroll 2
                    for (int k = 0; k < 8; ++k) {
                        const int idx = tid + 512 * k, tl = idx >> 3, ch = idx & 7;
                        const float l0 = lse_run[tl], l1 = lse_cur[tl], mx = fmaxf(l0, l1);
                        float w0 = att::ex2(l0 - mx), w1 = att::ex2(l1 - mx); const float sm = w0 + w1, inv = 1.0f / sm; w0 *= inv; w1 *= inv;
                        const pg8::u32x4 a0 = *(const LAS pg8::u32x4*)(og_run + (size_t)tl * 64 + 8 * (ch ^ ((tl ^ (tl >> 2) ^ (tl >> 4)) & 7))), a1 = *(const LAS pg8::u32x4*)(og_cur + (size_t)tl * 64 + 8 * (ch ^ ((tl ^ (tl >> 2) ^ (tl >> 4)) & 7)));
                        pg8::u32x4 res;
#pragma unroll
                        for (int e = 0; e < 4; ++e) res[e] = pg8::cvtpk(w0 * __uint_as_float(a0[e] << 16) + w1 * __uint_as_float(a1[e] << 16), w0 * __uint_as_float(a0[e] & 0xffff0000u) + w1 * __uint_as_float(a1[e] & 0xffff0000u));
                        *(LAS pg8::u32x4*)(og_run + (size_t)tl * 64 + 8 * (ch ^ ((tl ^ (tl >> 2) ^ (tl >> 4)) & 7))) = res;
                        if (ch == 0) lse_tmp[tl] = mx + att::lg2(sm);
                    }
                    __syncthreads();
                }
                const int g = j >> 1, dsh = 2 * g, q16 = 2 * wave + (j & 1);
                const int r = (g == 0) ? 0 : (g == 1 ? (q16 >> 2) : q16);
                const int i0 = (g == 0) ? (T0 + 32 * q16) : (g == 1 ? ((T0 >> 2) + 32 * (q16 & 3)) : (T0 >> 4));
                const float slope2 = exp2f(-(float)(g * 8 + h + 1) * (1.0f / 3.0f)) * 1.4426950408889634f;
                att::dil_tile(g, dsh, b, h, r, i0, 32, T0, PB, KT, VT1, slope2, g == 0 ? og_run : og_cur, g == 0 ? lse_run : lse_cur, lane, skip2);
            }
            __syncthreads();
            pg8::u32x4 gtv[8];
#pragma unroll
            for (int k = 0; k < 8; ++k) { const int idx = tid + 512 * k; gtv[k] = *(const pg8::u32x4*)(PB + (size_t)48 * 1024 * 1024 + ((size_t)b * SEQ + T0 + (idx >> 3)) * 512 + h * 64 + 8 * (idx & 7)); }
#pragma unroll
            for (int k = 0; k < 8; ++k) {
                const int idx = tid + 512 * k, tl = idx >> 3, ch = idx & 7;
                const float l0 = lse_tmp[tl], l1 = lse_cur[tl], mx = fmaxf(l0, l1);
                float w0 = att::ex2(l0 - mx), w1 = att::ex2(l1 - mx); const float inv = 1.0f / (w0 + w1); w0 *= inv; w1 *= inv;
                const pg8::u32x4 a0 = *(const LAS pg8::u32x4*)(og_run + (size_t)tl * 64 + 8 * (ch ^ ((tl ^ (tl >> 2) ^ (tl >> 4)) & 7))), a1 = *(const LAS pg8::u32x4*)(og_cur + (size_t)tl * 64 + 8 * (ch ^ ((tl ^ (tl >> 2) ^ (tl >> 4)) & 7)));
                const size_t tok = (size_t)b * SEQ + T0 + tl;
                const pg8::u32x4 gt = gtv[k];
                pg8::u32x4 res;
#pragma unroll
                for (int e = 0; e < 4; ++e) {
                    const float lo = (w0 * __uint_as_float(a0[e] << 16) + w1 * __uint_as_float(a1[e] << 16)) * __uint_as_float(gt[e] << 16);
                    const float hi = (w0 * __uint_as_float(a0[e] & 0xffff0000u) + w1 * __uint_as_float(a1[e] & 0xffff0000u)) * __uint_as_float(gt[e] & 0xffff0000u);
                    res[e] = pg8::cvtpk(lo, hi);
                }
                *(pg8::u32x4*)(MIX1 + tok * 512 + h * 64 + 8 * ch) = res;
            }
            __syncthreads();
          }
        }
    }
#endif
    XBAR();

#ifdef EXTRA_SYNCS
    for (int es = 0; es < EXTRA_SYNCS; ++es) XBAR();
#endif
#if PH_MASK & 64
    { PHASE_IDS
        pg8::Gemm g{MIX1, W1O, MTOK, 1024, 512, 512, 0}; pg8::StaticOrder S; S.init(MTOK, 1024, G, (int)blockIdx.x);
#if REP6 > 1
        { pg8::EpiOut1 E0{XB, out}; pg8::gemm_phase<pg8::EpiOut1, pg8::StaticOrder, true, true>(lds, g, S, E0); }
#endif
        pg8::EpiOut1 E{XB, out};
        pg8::gemm_phase<pg8::EpiOut1, pg8::StaticOrder, true, true>(lds, g, S, E);
    }
#endif
}

extern "C" void kernel_launch(void* const* d_in, const int* in_sizes, int n_in, void* d_out, int out_size, void* d_ws, size_t ws_size, hipStream_t stream) {
    static int grid_blocks = 0;
    if (grid_blocks == 0) {
        if (n_in != 12 || ws_size < WS_END) { fprintf(stderr, "kernel_launch: unexpected inputs (n_in %d, ws %zu)\n", n_in, ws_size); grid_blocks = -1; return; }
        int dev = 0, cus = 0, per_cu = 0;
        (void)hipGetDevice(&dev);
        (void)hipDeviceGetAttribute(&cus, hipDeviceAttributeMultiprocessorCount, dev);
        if (hipFuncSetAttribute((const void*)mk_fwd, hipFuncAttributeMaxDynamicSharedMemorySize, LDS_BYTES) != hipSuccess) { fprintf(stderr, "kernel_launch: hipFuncSetAttribute failed\n"); grid_blocks = -1; return; }
        if (hipOccupancyMaxActiveBlocksPerMultiprocessor(&per_cu, (const void*)mk_fwd, 512, LDS_BYTES) != hipSuccess || per_cu < 1) { fprintf(stderr, "kernel_launch: occupancy query gives %d\n", per_cu); (void)hipGetLastError(); per_cu = 1; }
        grid_blocks = cus * 1;
        if (grid_blocks > cus * per_cu) grid_blocks = cus * per_cu;
    }
    if (grid_blocks < 0) return;
    Args a{};
    for (int i = 0; i < 12; ++i) a.in[i] = (const float*)d_in[i];
    a.out = (float*)d_out; a.ws = (unsigned char*)d_ws;
    void* kargs[] = {&a};
    hipError_t e = hipLaunchCooperativeKernel((const void*)mk_fwd, dim3(grid_blocks), dim3(512), kargs, LDS_BYTES, stream);
    if (e != hipSuccess) fprintf(stderr, "kernel_launch: cooperative launch failed: %s (grid %d)\n", hipGetErrorString(e), grid_blocks);
}
```
